# Optimizing an MI355X kernel written in HIP

```python
import jax
import jax.numpy as jnp
from jax import lax
import numpy as np

D_MODEL = 2048
BATCH = 16
SEQ = 2048
DEPTH = 2
DEC_BATCH = 4
DEC_SEQ = 8192
PAST_LEN = 128

HEAD_DIM = 128
MIX_HEADS = D_MODEL // HEAD_DIM
MEM_HEADS = 4
TOK_HEADS = MIX_HEADS - MEM_HEADS
TOK_WIDTH = TOK_HEADS * HEAD_DIM
MEM_WIDTH = MEM_HEADS * HEAD_DIM
MIX_WIDTH = TOK_WIDTH + MEM_WIDTH
N_MEM = 256
D_FF = 4 * D_MODEL
N_MIXERS = 2
N_RET = (DEPTH + 1) // 2
N_NA = DEPTH // 2
RET_CHUNK = 128
RET_DECAY_BASE = 5.0
ROPE_BASE = 10000.0
GRID_W = 64
NA_KH_MAX = 8
NA_KW = 16
NA_COL_BLOCK = 16
NA_COL_SPAN = 32
N_COL_BLOCKS = GRID_W // NA_COL_BLOCK
NORM_EPS = 1e-6

kernel_name = 'hybrid_retention_natten_encoder'


def rms_norm(x, gain):
    xf = x.astype(jnp.float32)
    xf = xf * lax.rsqrt(jnp.mean(xf * xf, axis=-1, keepdims=True) + NORM_EPS)
    return (xf * gain.astype(jnp.float32)).astype(x.dtype)


def rotary(x):
    l, dh = x.shape[1], x.shape[-1]
    half = dh // 2
    inv_freq = ROPE_BASE ** (-jnp.arange(half, dtype=jnp.float32) / half)
    ang = jnp.arange(l, dtype=jnp.float32)[:, None] * inv_freq[None, :]
    cos = jnp.cos(ang)[None, :, None, :]
    sin = jnp.sin(ang)[None, :, None, :]
    xf = x.astype(jnp.float32)
    x1, x2 = xf[..., :half], xf[..., half:]
    return jnp.concatenate([x1 * cos - x2 * sin, x1 * sin + x2 * cos], axis=-1)


def retention_one_direction(q, k, v, log_gamma, strict):
    b, h, n, c, dh = q.shape
    idx = jnp.arange(c, dtype=jnp.float32)
    diff = idx[:, None] - idx[None, :]
    mask = (diff > 0) if strict else (diff >= 0)
    decay_intra = jnp.where(mask[None], jnp.exp(jnp.where(mask, diff, 0.0)[None] * log_gamma[:, None, None]), 0.0)
    scores = jnp.einsum('bhnid,bhnjd->bhnij', q, k) * decay_intra[None, :, None]
    y_intra = jnp.einsum('bhnij,bhnjd->bhnid', scores, v)
    k_decay = jnp.exp((c - 1 - idx)[None, :] * log_gamma[:, None])
    kv = jnp.einsum('bhnjd,bhnje->nbhde', k * k_decay[None, :, None, :, None], v)
    chunk_decay = jnp.exp(c * log_gamma)[None, :, None, None]

    def step(state, kv_n):
        return chunk_decay * state + kv_n, state

    _, states = lax.scan(step, jnp.zeros((b, h, dh, dh), jnp.float32), kv)
    q_decay = jnp.exp((idx + 1.0)[None, :] * log_gamma[:, None])
    y_cross = jnp.einsum('bhnid,nbhde->bhnie', q * q_decay[None, :, None, :, None], states)
    return y_intra + y_cross


def retention_mixer(q, k, v, gate, decay_exp):
    b, l, _ = q.shape
    n = l // RET_CHUNK
    log_gamma = jnp.log1p(-jnp.exp2(-decay_exp.astype(jnp.float32)))
    heads = lambda t: t.reshape(b, l, TOK_HEADS, HEAD_DIM)
    qr = rotary(heads(q))
    kr = rotary(heads(k)) * (HEAD_DIM ** -0.5)
    vf = heads(v).astype(jnp.float32)
    chunks = lambda t: t.reshape(b, n, RET_CHUNK, TOK_HEADS, HEAD_DIM).transpose(0, 3, 1, 2, 4)
    qc, kc, vc = chunks(qr), chunks(kr), chunks(vf)
    flip = lambda t: t[:, :, ::-1, ::-1]
    y = (retention_one_direction(qc, kc, vc, log_gamma[0], False)
         + flip(retention_one_direction(flip(qc), flip(kc), flip(vc), log_gamma[1], True)))
    y = y.transpose(0, 2, 3, 1, 4).reshape(b, l, TOK_HEADS, HEAD_DIM)
    y = y * lax.rsqrt(jnp.mean(y * y, axis=-1, keepdims=True) + NORM_EPS)
    return jax.nn.silu(gate) * y.reshape(b, l, TOK_WIDTH).astype(gate.dtype)


def na_column_tables():
    cb = np.arange(N_COL_BLOCKS)
    q_col = cb[:, None] * NA_COL_BLOCK + np.arange(NA_COL_BLOCK)[None, :]
    win_start = np.clip(q_col - NA_KW // 2, 0, GRID_W - NA_KW)
    blk_start = np.clip(cb * NA_COL_BLOCK - NA_KW // 2, 0, GRID_W - NA_COL_SPAN)
    key_col = blk_start[:, None] + np.arange(NA_COL_SPAN)[None, :]
    kcol = key_col[:, None, :]
    valid = (kcol >= win_start[:, :, None]) & (kcol < win_start[:, :, None] + NA_KW)
    dc_idx = np.clip(kcol - q_col[:, :, None] + NA_KW - 1, 0, 2 * NA_KW - 2)
    return key_col, valid, dc_idx


def neighbourhood_mixer(q, k, v, rpb):
    b, l, _ = q.shape
    rows = l // GRID_W
    kh = min(NA_KH_MAX, rows)
    key_col, valid, dc_idx = na_column_tables()
    qg = q.reshape(b, rows, N_COL_BLOCKS, NA_COL_BLOCK, TOK_HEADS, HEAD_DIM)
    kg = k.reshape(b, rows, GRID_W, TOK_HEADS, HEAD_DIM)[:, :, key_col]
    vg = v.reshape(b, rows, GRID_W, TOK_HEADS, HEAD_DIM)[:, :, key_col]
    rpb_f = rpb.astype(jnp.float32)
    scale = HEAD_DIM ** -0.5

    def row_block(r):
        rs = jnp.clip(r - kh // 2, 0, rows - kh)
        k_win = lax.dynamic_slice_in_dim(kg, rs, kh, axis=1)
        v_win = lax.dynamic_slice_in_dim(vg, rs, kh, axis=1)
        q_row = lax.dynamic_index_in_dim(qg, r, axis=1, keepdims=False)
        s = jnp.einsum('bcqhd,brckhd->bhcqrk', q_row, k_win).astype(jnp.float32) * scale
        dr_idx = rs + jnp.arange(kh) - r + (NA_KH_MAX - 1)
        bias = rpb_f[:, dr_idx][:, :, dc_idx].transpose(0, 2, 3, 1, 4)
        s = jnp.where(valid[:, :, None, :], s + bias[None], -jnp.inf)
        p = jax.nn.softmax(s, axis=(-2, -1)).astype(v_win.dtype)
        return jnp.einsum('bhcqrk,brckhd->bcqhd', p, v_win)

    out = lax.map(row_block, jnp.arange(rows))
    return out.transpose(1, 0, 2, 3, 4, 5).reshape(b, l, TOK_WIDTH)


def memory_attention(q, mem_k, mem_v):
    s = jnp.einsum('blhd,bmhd->bhlm', q, mem_k).astype(jnp.float32) * (HEAD_DIM ** -0.5)
    p = jax.nn.softmax(s, axis=-1).astype(mem_v.dtype)
    return jnp.einsum('bhlm,bmhd->blhd', p, mem_v)


def run_trunk(x, mem, norm_gain, mem_norm_gain, w_mem_kv, w_out, w_mlp_in, w_mlp_out,
              w_in_ret, ret_decay, w_in_na, na_rpb):
    b, l, _ = x.shape
    for i in range(DEPTH):
        g = norm_gain[i]
        h = rms_norm(x, g[0])
        m = rms_norm(mem, mem_norm_gain[i])
        mem_k, mem_v = jnp.split(m @ w_mem_kv[i], 2, axis=-1)
        mem_k = mem_k.reshape(b, N_MEM, MEM_HEADS, HEAD_DIM)
        mem_v = mem_v.reshape(b, N_MEM, MEM_HEADS, HEAD_DIM)
        j = i // N_MIXERS
        if i % N_MIXERS == 0:
            q, k, v, gate, q_mem = jnp.split(h @ w_in_ret[j], [TOK_WIDTH, 2 * TOK_WIDTH, 3 * TOK_WIDTH, 4 * TOK_WIDTH], axis=-1)
            tok = retention_mixer(q, k, v, gate, ret_decay[j])
        else:
            q, k, v, q_mem = jnp.split(h @ w_in_na[j], [TOK_WIDTH, 2 * TOK_WIDTH, 3 * TOK_WIDTH], axis=-1)
            tok = neighbourhood_mixer(q, k, v, na_rpb[j])
        mem_out = memory_attention(q_mem.reshape(b, l, MEM_HEADS, HEAD_DIM), mem_k, mem_v).reshape(b, l, MEM_WIDTH)
        mixed = jnp.concatenate([tok, mem_out], axis=-1) @ w_out[i]
        x = x + rms_norm(mixed, g[1])
        u = jnp.square(jax.nn.relu(rms_norm(x, g[2]) @ w_mlp_in[i]))
        x = x + rms_norm(u @ w_mlp_out[i], g[3])
    return x


def setup_inputs(seed: int = 0) -> dict:
    key = jax.random.key(seed)
    ks = jax.random.split(key, 14)
    normal = lambda k, shape: jax.random.normal(k, shape, jnp.float32)
    lin = lambda k, shape, fan_in: normal(k, shape) * (fan_in ** -0.5)
    decay_init = RET_DECAY_BASE + jnp.arange(TOK_HEADS, dtype=jnp.float32)[None, None, :]
    return {
        'x_prompt': normal(ks[0], (BATCH, SEQ, D_MODEL)),
        'x_sample': normal(ks[1], (DEC_BATCH, DEC_SEQ, D_MODEL)),
        'mem_prompt': normal(ks[2], (BATCH, N_MEM, D_MODEL)),
        'mem_sample': normal(ks[3], (DEC_BATCH, N_MEM, D_MODEL)),
        'norm_gain': 1.0 + 0.02 * normal(ks[4], (DEPTH, 4, D_MODEL)),
        'mem_norm_gain': 1.0 + 0.02 * normal(ks[5], (DEPTH, D_MODEL)),
        'w_mem_kv': lin(ks[6], (DEPTH, D_MODEL, 2 * MEM_WIDTH), D_MODEL),
        'w_out': lin(ks[7], (DEPTH, MIX_WIDTH, D_MODEL), MIX_WIDTH),
        'w_mlp_in': lin(ks[8], (DEPTH, D_MODEL, D_FF), D_MODEL),
        'w_mlp_out': lin(ks[9], (DEPTH, D_FF, D_MODEL), D_FF),
        'w_in_ret': lin(ks[10], (N_RET, D_MODEL, 4 * TOK_WIDTH + MEM_WIDTH), D_MODEL),
        'ret_decay': decay_init + 0.1 * normal(ks[11], (N_RET, 2, TOK_HEADS)),
        'w_in_na': lin(ks[12], (N_NA, D_MODEL, 3 * TOK_WIDTH + MEM_WIDTH), D_MODEL),
        'na_rpb': 0.05 * normal(ks[13], (N_NA, TOK_HEADS, 2 * NA_KH_MAX - 1, 2 * NA_KW - 1)),
    }


def reference(x_prompt, x_sample, mem_prompt, mem_sample, norm_gain, mem_norm_gain, w_mem_kv, w_out,
              w_mlp_in, w_mlp_out, w_in_ret, ret_decay, w_in_na, na_rpb):
    y_prompt = run_trunk(x_prompt, mem_prompt, norm_gain, mem_norm_gain, w_mem_kv, w_out, w_mlp_in, w_mlp_out,
                         w_in_ret, ret_decay, w_in_na, na_rpb)
    y_sample = run_trunk(x_sample, mem_sample, norm_gain, mem_norm_gain, w_mem_kv, w_out, w_mlp_in, w_mlp_out,
                         w_in_ret, ret_decay, w_in_na, na_rpb)
    return (y_prompt, y_sample)
```

```cpp
#include <hip/hip_runtime.h>
#include <hip/hip_cooperative_groups.h>
#include <cstdio>
#include <cstdint>
namespace cg = cooperative_groups;
namespace pg8 {
#define PG8_LAS __attribute__((address_space(3)))
typedef unsigned short bf16_t;
typedef short bf16x8 __attribute__((ext_vector_type(8)));
typedef float f32x4 __attribute__((ext_vector_type(4)));
typedef unsigned u32x4 __attribute__((ext_vector_type(4)));
constexpr int BM = 256, BK = 64, HALF = 128, HTB = HALF * BK * 2  , STAGE_BYTES = 8 * HTB, NXCD = 8, WGM = 4;

__host__ __device__ __forceinline__ int lds_byte(int r, int c) { const int st = (r >> 4) * 2 + (c >> 5), rr = r & 15, cc = c & 31, ob = rr * 64 + cc * 2; return st * 1024 + (ob ^ (((ob >> 9) & 1) << 5)); }
__host__ __device__ __forceinline__ void stage_rc(int b, int& R, int& C) { const int st = b / 1024, sb = b % 1024, swz = sb ^ (((sb >> 9) & 1) << 5); R = (st >> 1) * 16 + swz / 64; C = (st & 1) * 32 + (swz % 64) / 2; }
__host__ __device__ __forceinline__ int perm32(int rho) { const int n = rho >> 4, i = rho & 15; return 8 * (i >> 2) + 4 * n + (i & 3); }

struct Unit { int pm, pn; };
struct Gemm { const bf16_t* A; const bf16_t* Bt; int M, N, K; };

struct StaticOrder {
    int nM, nN, nwg, G, c;
    __host__ __device__ void init(int M, int N, int G_, int c_) { nM = M / BM; nN = N / BM; nwg = nM * nN; G = G_; c = c_; }
    __host__ __device__ bool next(int i, Unit& u) const {
        const long L = (long)i * G + c; if (L >= nwg) return false;
        int wgid = (int)L; { const int q = nwg / NXCD, r = nwg % NXCD, xcd = wgid % NXCD, off = wgid / NXCD; wgid = (xcd < r ? xcd * (q + 1) : r * (q + 1) + (xcd - r) * q) + off; }
        const int nig = WGM * nN, gid = wgid / nig, fm = gid * WGM, gsz = (nM - fm) < WGM ? (nM - fm) : WGM;
        u.pm = fm + ((wgid % nig) % gsz); u.pn = (wgid % nig) / gsz; return true;
    }
    __device__ __forceinline__ void a_ready(const Unit&) const {}
    __device__ __forceinline__ void done(const Unit&) const {}
};

__device__ __forceinline__ unsigned cvt_pk_bf16(float lo, float hi) { unsigned r; asm volatile("v_cvt_pk_bf16_f32 %0, %1, %2" : "=v"(r) : "v"(lo), "v"(hi)); return r; }
struct EpiAct {
    static constexpr bool PERM = true, AFTER_DRAIN = false;
    bf16_t* O; int ldc; int act; const float* rs;
    __device__ __forceinline__ void operator()(const f32x4 (&acc)[2][2][4][2], const Unit& u, int wr, int wc, int fr, int fq) const {
        const int row0 = u.pm * BM + wr * 64 + fr; const int col0 = u.pn * BM + wc * 32 + 8 * fq;
#pragma unroll
        for (int ai = 0; ai < 2; ++ai)
#pragma unroll
            for (int m = 0; m < 4; ++m) { const int row = row0 + ai * HALF + m * 16; bf16_t* rowp = O + (size_t)row * ldc + col0;
                const float sc = rs ? rs[row] : 1.0f;
#pragma unroll
                for (int bj = 0; bj < 2; ++bj) { f32x4 v0 = acc[ai][bj][m][0] * sc, v1 = acc[ai][bj][m][1] * sc;
                    if (act) {
#pragma unroll
                        for (int j = 0; j < 4; ++j) { const float a = fmaxf(v0[j], 0.f), b = fmaxf(v1[j], 0.f); v0[j] = a * a; v1[j] = b * b; } }
                    u32x4 w; w.x = cvt_pk_bf16(v0[0], v0[1]); w.y = cvt_pk_bf16(v0[2], v0[3]); w.z = cvt_pk_bf16(v1[0], v1[1]); w.w = cvt_pk_bf16(v1[2], v1[3]);
                    *(u32x4*)(rowp + bj * HALF) = w; } }
    }
};
template <class Epi, class Sched, bool ALIGN_EPI = false, bool SP2 = false>
__device__ __forceinline__ void gemm_phase(PG8_LAS unsigned char* lds, const Gemm g, const Sched& S, const Epi& E) {
    int tid_l = threadIdx.x; asm volatile("" : "+v"(tid_l)); const int tid = tid_l, wid = __builtin_amdgcn_readfirstlane(tid >> 6), lane = tid & 63, wr = wid >> 2, wc = wid & 3, fr = lane & 15, fq = lane >> 4;
    const int K = g.K, nt = K / BK;
    unsigned voffA[2], voffB[2];
#pragma unroll
    for (int i = 0; i < 2; ++i) { int R, C; stage_rc(tid * 16 + i * 8192, R, C); const int Rb = Epi::PERM ? ((R & ~31) + perm32(R & 31)) : R;
        voffA[i] = (unsigned)(R * K + C) * 2u; voffB[i] = (unsigned)(Rb * K + C) * 2u; }
    const size_t kstep = (size_t)(BK * 2);
    const size_t hstep = (size_t)HALF * K * 2;
    const size_t tstep = 2 * hstep;
    const unsigned ldsw = (unsigned)wid * 1024u;
    const int aoff = lds_byte(wr * 64 + fr, fq * 8), boff = lds_byte(wc * 32 + fr, fq * 8);
#define PG8_SA(b, h) (((b) * 2 + (h)) * HTB)
#define PG8_SB(b, h) ((4 + (b) * 2 + (h)) * HTB)
#define PG8_STAGE(bufoff, gbase, voff) do { _Pragma("unroll") for (int _i = 0; _i < 2; ++_i) \
        __builtin_amdgcn_global_load_lds((const unsigned*)((const char*)(gbase) + (voff)[_i]), (PG8_LAS unsigned*)(lds + (bufoff) + ldsw + _i * 8192), 16, 0, 0); } while (0)
#define PG8_LDA(dst, b, h) do { _Pragma("unroll") for (int m = 0; m < 4; ++m) _Pragma("unroll") for (int k = 0; k < 2; ++k) dst[m][k] = *(const PG8_LAS bf16x8*)(lds + PG8_SA(b, h) + aoff + m * 2048 + k * 1024); } while (0)
#define PG8_LDB(dst, b, h) do { _Pragma("unroll") for (int n = 0; n < 2; ++n) _Pragma("unroll") for (int k = 0; k < 2; ++k) dst[n][k] = *(const PG8_LAS bf16x8*)(lds + PG8_SB(b, h) + boff + n * 2048 + k * 1024); } while (0)
#define PG8_MMA(ai, bj, At, Bt) do { __builtin_amdgcn_s_setprio(1); _Pragma("unroll") for (int m = 0; m < 4; ++m) _Pragma("unroll") for (int n = 0; n < 2; ++n) _Pragma("unroll") for (int k = 0; k < 2; ++k) \
        acc[ai][bj][m][n] = __builtin_amdgcn_mfma_f32_16x16x32_bf16(Bt[n][k], At[m][k], acc[ai][bj][m][n], 0, 0, 0); __builtin_amdgcn_s_setprio(0); } while (0)
#define PG8_WAIT_V(n) asm volatile("s_waitcnt vmcnt(" #n ")" ::: "memory")
#define PG8_WAIT_L(n) asm volatile("s_waitcnt lgkmcnt(" #n ")" ::: "memory")
#define PG8_BAR __builtin_amdgcn_s_barrier()
#define PG8_SCHED __builtin_amdgcn_sched_barrier(0)
    Unit cur, nxt; int ui = 0;
    if (!S.next(0, cur)) return;
    f32x4 acc[2][2][4][2];
#pragma unroll
    for (int a = 0; a < 2; ++a)
#pragma unroll
        for (int b = 0; b < 2; ++b)
#pragma unroll
            for (int m = 0; m < 4; ++m)
#pragma unroll
                for (int n = 0; n < 2; ++n) acc[a][b][m][n] = (f32x4){0.f, 0.f, 0.f, 0.f};
    bf16x8 At[4][2], B0[2][2], B1[2][2];
    const char* cA = (const char*)g.A + (size_t)cur.pm * tstep; const char* cB = (const char*)g.Bt + (size_t)cur.pn * tstep;
    S.a_ready(cur);
    if constexpr (SP2) {
        PG8_STAGE(PG8_SB(0, 0), cB, voffB); PG8_STAGE(PG8_SB(0, 1), cB + hstep, voffB); PG8_STAGE(PG8_SA(0, 0), cA, voffA); PG8_STAGE(PG8_SA(0, 1), cA + hstep, voffA);
        if (wr == 1) PG8_BAR;
        PG8_WAIT_V(2); PG8_BAR;
        PG8_STAGE(PG8_SB(1, 0), cB + kstep, voffB); PG8_STAGE(PG8_SA(1, 0), cA + kstep, voffA); PG8_STAGE(PG8_SB(1, 1), cB + hstep + kstep, voffB);
        PG8_WAIT_V(6); PG8_BAR;
    } else {
        PG8_STAGE(PG8_SB(0, 0), cB, voffB); PG8_STAGE(PG8_SA(0, 0), cA, voffA); PG8_STAGE(PG8_SB(0, 1), cB + hstep, voffB); PG8_STAGE(PG8_SA(0, 1), cA + hstep, voffA);
        if (wr == 1) PG8_BAR;
        PG8_WAIT_V(4); PG8_BAR;
        PG8_STAGE(PG8_SB(1, 0), cB + kstep, voffB); PG8_STAGE(PG8_SA(1, 0), cA + kstep, voffA); PG8_STAGE(PG8_SB(1, 1), cB + hstep + kstep, voffB);
        PG8_WAIT_V(6); PG8_BAR;
    }
    for (;;) {
        const bool has_next = S.next(ui + 1, nxt);
        const char* nA = has_next ? (const char*)g.A + (size_t)nxt.pm * tstep : cA; const char* nB = has_next ? (const char*)g.Bt + (size_t)nxt.pn * tstep : cB;
        for (int t = 0; t < nt; t += 2) {
            const bool last = (t == nt - 2);
            const char* a1 = cA + (size_t)(t + 1) * kstep;
            const char* a2 = last ? nA : cA + (size_t)(t + 2) * kstep; const char* b2 = last ? nB : cB + (size_t)(t + 2) * kstep;
            const char* a3 = a2 + kstep; const char* b3 = b2 + kstep;
            if (last && has_next) S.a_ready(nxt);
            if constexpr (SP2) {
            PG8_LDB(B0, 0, 0); PG8_LDB(B1, 0, 1); PG8_SCHED; PG8_LDA(At, 0, 0); PG8_STAGE(PG8_SA(1, 1), a1 + hstep, voffA);
            PG8_WAIT_V(8); PG8_WAIT_L(0); PG8_BAR; PG8_MMA(0, 0, At, B0); PG8_MMA(0, 1, At, B1); PG8_BAR; PG8_SCHED;
            PG8_LDA(At, 0, 1); PG8_STAGE(PG8_SB(0, 0), b2, voffB); PG8_STAGE(PG8_SB(0, 1), b2 + hstep, voffB); PG8_STAGE(PG8_SA(0, 0), a2, voffA);
            PG8_WAIT_V(8); PG8_WAIT_L(0); PG8_BAR; PG8_MMA(1, 0, At, B0); PG8_MMA(1, 1, At, B1); PG8_BAR; PG8_SCHED;
            PG8_LDB(B0, 1, 0); PG8_LDB(B1, 1, 1); PG8_SCHED; PG8_LDA(At, 1, 0); PG8_STAGE(PG8_SA(0, 1), a2 + hstep, voffA);
            PG8_WAIT_V(8); PG8_WAIT_L(0); PG8_BAR; PG8_MMA(0, 0, At, B0); PG8_MMA(0, 1, At, B1); PG8_BAR; PG8_SCHED;
            PG8_LDA(At, 1, 1); PG8_STAGE(PG8_SB(1, 0), b3, voffB); PG8_STAGE(PG8_SB(1, 1), b3 + hstep, voffB); PG8_STAGE(PG8_SA(1, 0), a3, voffA);
            PG8_WAIT_V(8); PG8_WAIT_L(0); PG8_BAR; PG8_MMA(1, 0, At, B0); PG8_MMA(1, 1, At, B1); PG8_BAR; PG8_SCHED;
            } else {
            PG8_LDB(B0, 0, 0); PG8_SCHED; PG8_LDA(At, 0, 0); PG8_STAGE(PG8_SA(1, 1), a1 + hstep, voffA);
            PG8_WAIT_L(8); PG8_BAR; PG8_WAIT_L(0); PG8_MMA(0, 0, At, B0); PG8_BAR; PG8_SCHED;
            PG8_LDB(B1, 0, 1); PG8_STAGE(PG8_SB(0, 0), b2, voffB);
            PG8_BAR; PG8_WAIT_L(0); PG8_MMA(0, 1, At, B1); PG8_BAR;
            PG8_LDA(At, 0, 1); PG8_STAGE(PG8_SA(0, 0), a2, voffA);
            PG8_BAR; PG8_WAIT_L(0); PG8_MMA(1, 0, At, B0); PG8_BAR; PG8_SCHED;
            PG8_STAGE(PG8_SB(0, 1), b2 + hstep, voffB);
            PG8_WAIT_V(6); PG8_BAR; PG8_MMA(1, 1, At, B1); PG8_BAR;
            PG8_LDB(B0, 1, 0); PG8_SCHED; PG8_LDA(At, 1, 0); PG8_STAGE(PG8_SA(0, 1), a2 + hstep, voffA);
            PG8_WAIT_L(8); PG8_BAR; PG8_WAIT_L(0); PG8_MMA(0, 0, At, B0); PG8_BAR; PG8_SCHED;
            PG8_LDB(B1, 1, 1); PG8_STAGE(PG8_SB(1, 0), b3, voffB);
            PG8_BAR; PG8_WAIT_L(0); PG8_MMA(0, 1, At, B1); PG8_BAR;
            PG8_LDA(At, 1, 1); PG8_STAGE(PG8_SA(1, 0), a3, voffA);
            PG8_BAR; PG8_WAIT_L(0); PG8_MMA(1, 0, At, B0); PG8_BAR; PG8_SCHED;
            PG8_STAGE(PG8_SB(1, 1), b3 + hstep, voffB);
            PG8_WAIT_V(6); PG8_BAR; PG8_MMA(1, 1, At, B1); PG8_BAR;
            }
        }
        if constexpr (ALIGN_EPI) { if (wr == 0) PG8_BAR; }
        if constexpr (!Epi::AFTER_DRAIN) { E(acc, cur, wr, wc, fr, fq); S.done(cur); }
        if (!has_next) break;
#pragma unroll
        for (int a = 0; a < 2; ++a)
#pragma unroll
            for (int b = 0; b < 2; ++b)
#pragma unroll
                for (int m = 0; m < 4; ++m)
#pragma unroll
                    for (int n = 0; n < 2; ++n) acc[a][b][m][n] = (f32x4){0.f, 0.f, 0.f, 0.f};
        cur = nxt; cA = nA; cB = nB; ++ui;
        if constexpr (ALIGN_EPI) { if (wr == 1) PG8_BAR; }
    }
    PG8_WAIT_V(0);
    if constexpr (!ALIGN_EPI) { if (wr == 0) PG8_BAR; }
    PG8_BAR;
    if constexpr (Epi::AFTER_DRAIN) { E.fused(acc, cur, wr, wc, fr, fq, lds, wid, lane); S.done(cur); }
#undef PG8_SA
#undef PG8_SB
#undef PG8_STAGE
#undef PG8_LDA
#undef PG8_LDB
#undef PG8_MMA
#undef PG8_WAIT_V
#undef PG8_WAIT_L
#undef PG8_BAR
#undef PG8_SCHED
}
}
#define LAS __attribute__((address_space(3)))
#define DI __device__ __forceinline__
typedef unsigned short bf16;
typedef short bf16x8 __attribute__((ext_vector_type(8)));
typedef short s16x4 __attribute__((ext_vector_type(4)));
typedef float f32x4 __attribute__((ext_vector_type(4)));
typedef unsigned v4u __attribute__((ext_vector_type(4)));
typedef unsigned v2u __attribute__((ext_vector_type(2)));

constexpr int D = 2048, MC = 16384, NROUND = 4;
constexpr int NIN0 = 6656, NIN1 = 5120, DFF = 8192, NTH = 12;
constexpr int MEMROWS = 5120;
constexpr float EPS = 1e-6f;
constexpr int LDS_BYTES = 147456;
constexpr int PITCH = 272;
constexpr int PPITCH = 528;
constexpr float QK_SCALE = 0.08838834764831845f;
constexpr float LOG2E = 1.4426950408889634f;

constexpr size_t MiB = 1u << 20;
constexpr size_t WS_RSTD = 65536;
constexpr size_t WS_WIN0 = 1 * MiB;
constexpr size_t WS_WIN1 = WS_WIN0 + (size_t)NIN0 * D * 2;
constexpr size_t WS_WOUT = WS_WIN1 + (size_t)NIN1 * D * 2;
constexpr size_t WS_WMI = WS_WOUT + 2 * (size_t)D * D * 2;
constexpr size_t WS_WMO = WS_WMI + 2 * (size_t)DFF * D * 2;
constexpr size_t WS_WMEM = WS_WMO + 2 * (size_t)DFF * D * 2;
constexpr size_t WS_MEMN = WS_WMEM + 2 * (size_t)1024 * D * 2;
constexpr size_t WS_MEMKV = WS_MEMN + 2 * (size_t)MEMROWS * D * 2;
constexpr size_t WS_ROPE = WS_MEMKV + 2 * (size_t)MEMROWS * 1024 * 2;
constexpr size_t WS_H = WS_ROPE + 2 * (size_t)8192 * 64 * 4;
constexpr size_t WS_QKV = WS_H + (size_t)MC * D * 2;
constexpr size_t WS_CAT = WS_QKV + (size_t)MC * DFF * 2;
constexpr size_t WS_MIX = WS_CAT + (size_t)MC * D * 2;
constexpr size_t WS_ST = WS_MIX + (size_t)MC * D * 2;
constexpr size_t WS_X16 = WS_ST + 2 * (size_t)128 * 12 * 16384 * 2;
constexpr size_t WS_END = WS_X16 + (size_t)MC * D * 2;

struct Params {
    const float *x_prompt, *x_sample, *mem_prompt, *mem_sample, *norm_gain, *mem_norm_gain, *w_mem_kv, *w_out, *w_mlp_in, *w_mlp_out, *w_in_ret, *ret_decay, *w_in_na, *na_rpb;
    float* out; unsigned char* ws;
};

DI float bf2f(unsigned short b) { return __builtin_bit_cast(float, (unsigned)b << 16); }
DI unsigned short f2bf_sw(float f) { unsigned u = __builtin_bit_cast(unsigned, f); return (unsigned short)((u + 0x7fffu + ((u >> 16) & 1u)) >> 16); }
DI unsigned pk2(float lo, float hi) { return pg8::cvt_pk_bf16(lo, hi); }
DI unsigned short f2bf(float f) { return (unsigned short)(pg8::cvt_pk_bf16(f, f) & 0xffffu); }
DI float fexp2(float x) { return __builtin_amdgcn_exp2f(x); }
DI float wave_sum(float v) {
#pragma unroll
    for (int o = 1; o < 64; o <<= 1) v += __shfl_xor(v, o);
    return v;
}
DI int lbid() { int b = (int)blockIdx.x; asm volatile("" : "+s"(b)); return b; }
DI int lgdim() { int g = (int)gridDim.x; asm volatile("" : "+s"(g)); return g; }
DI float grp16_sum(float v) { v += __shfl_xor(v, 1); v += __shfl_xor(v, 2); v += __shfl_xor(v, 4); v += __shfl_xor(v, 8); return v; }
DI float grp16_max(float v) { v = fmaxf(v, __shfl_xor(v, 1)); v = fmaxf(v, __shfl_xor(v, 2)); v = fmaxf(v, __shfl_xor(v, 4)); v = fmaxf(v, __shfl_xor(v, 8)); return v; }
DI f32x4 mfma16(bf16x8 a, bf16x8 b, f32x4 c) { return __builtin_amdgcn_mfma_f32_16x16x32_bf16(a, b, c, 0, 0, 0); }
DI bf16x8 frag_row(const LAS unsigned char* img, int pitch, int r0, int k0, int lane) {
    return *(const LAS bf16x8*)(img + (r0 + (lane & 15)) * pitch + (k0 + 8 * (lane >> 4)) * 2);
}
DI bf16x8 frag_tr(const LAS unsigned char* img, int pitch, int k0, int c0, int lane) {
    const int g = lane >> 4, q = (lane & 15) >> 2, p = lane & 3;
    const LAS unsigned char* a = img + (k0 + 8 * g + q) * pitch + (c0 + 4 * p) * 2;
    const s16x4 lo = __builtin_amdgcn_ds_read_tr16_b64_v4i16((LAS s16x4*)a);
    const s16x4 hi = __builtin_amdgcn_ds_read_tr16_b64_v4i16((LAS s16x4*)(a + 4 * pitch));
    return __builtin_shufflevector(lo, hi, 0, 1, 2, 3, 4, 5, 6, 7);
}
DI bf16x8 frag_tr2(const LAS unsigned char* img, int pitch, int rb0, int rb1, int c0, int lane) {
    const int g = lane >> 4, q = (lane & 15) >> 2, p = lane & 3;
    const s16x4 lo = __builtin_amdgcn_ds_read_tr16_b64_v4i16((LAS s16x4*)(img + (rb0 + 4 * g + q) * pitch + (c0 + 4 * p) * 2));
    const s16x4 hi = __builtin_amdgcn_ds_read_tr16_b64_v4i16((LAS s16x4*)(img + (rb1 + 4 * g + q) * pitch + (c0 + 4 * p) * 2));
    return __builtin_shufflevector(lo, hi, 0, 1, 2, 3, 4, 5, 6, 7);
}
DI const float* xin_row(const Params& P, int t) { return t < 32768 ? P.x_prompt + (size_t)t * D : P.x_sample + (size_t)(t - 32768) * D; }

#define XB_TMO      128
#define XB_XCNT(j)  (256  + 64 * (j))
#define XB_XSUB(j)  (1280 + 64 * (j))
#define XB_XGEN(j)  (2304 + 64 * (j))
#define XB_TOP      3328
#define XB_TOPGEN   3392
#define XCD_BAR_WORDS 3456
#define XB_SPIN_CAP (1u << 18)

__device__ __forceinline__ unsigned xb_ld(unsigned* p)              { return __hip_atomic_load(p, __ATOMIC_RELAXED, __HIP_MEMORY_SCOPE_AGENT); }
__device__ __forceinline__ unsigned xb_add(unsigned* p, unsigned v) { return __hip_atomic_fetch_add(p, v, __ATOMIC_RELAXED, __HIP_MEMORY_SCOPE_AGENT); }
__device__ __forceinline__ unsigned xb_xcc_id() { return (unsigned)__builtin_amdgcn_s_getreg((3 << 11) | 20) & 0xFu; }
#define XB_SPIN(cond, bar) do { unsigned _sp = 0; while (cond) { __builtin_amdgcn_s_sleep(1); \
    if ((++_sp & 255u) == 0u) { if (xb_ld(&(bar)[XB_TMO])) break; if (_sp > XB_SPIN_CAP) { atomicAdd(&(bar)[XB_TMO], 1u); break; } } } } while (0)

struct XcdBarrier {
    unsigned* bar; unsigned x;
    volatile LAS unsigned* st;
};

__device__ __forceinline__ XcdBarrier xcd_barrier_post(unsigned* bar, volatile LAS unsigned* st) {
    XcdBarrier b; b.bar = bar; b.x = xb_xcc_id(); b.st = st;
    if (threadIdx.x == 0) (void)xb_add(&bar[XB_XCNT(b.x)], 1u);
    return b;
}
__device__ __forceinline__ void xcd_barrier_complete(unsigned* bar, unsigned x, unsigned& nloc, unsigned& nx) {
    const unsigned G = gridDim.x * gridDim.y * gridDim.z;
    unsigned sum, cnt, mine, sp = 0u;
    for (;;) {
        sum = 0u; cnt = 0u; mine = 0u;
#pragma unroll
        for (unsigned j = 0; j < 16; ++j) { const unsigned c = xb_ld(&bar[XB_XCNT(j)]); sum += c; cnt += (c > 0u) ? 1u : 0u; mine = (j == x) ? c : mine; }
        if (sum == G) break;
        __builtin_amdgcn_s_sleep(1);
        if ((++sp & 255u) == 0u) { if (xb_ld(&bar[XB_TMO])) break; if (sp > XB_SPIN_CAP) { atomicAdd(&bar[XB_TMO], 1u); break; } }
    }
    nloc = mine > 0u ? mine : 1u; nx = cnt > 0u ? cnt : 1u;
}

__device__ __forceinline__ void xcd_barrier(const XcdBarrier& b) {
    asm volatile("s_waitcnt vmcnt(0)" ::: "memory");
    __syncthreads();
    if (threadIdx.x == 0) {
        unsigned* bar = b.bar;
        __builtin_amdgcn_s_waitcnt(0);
        unsigned nloc = b.st[0], nx = b.st[1];
        if (nloc == 0u) { xcd_barrier_complete(bar, b.x, nloc, nx); b.st[0] = nloc; b.st[1] = nx; }
        const unsigned old = xb_add(&bar[XB_XSUB(b.x)], 1u);
        const unsigned gen = old / nloc;
        if (old + 1u == (gen + 1u) * nloc) {
            __builtin_amdgcn_fence(__ATOMIC_RELEASE, "agent");
            asm volatile("s_waitcnt vmcnt(0)" ::: "memory");
            const unsigned og = xb_add(&bar[XB_TOP], 1u);
            const unsigned tg = og / nx;
            if (og + 1u == (tg + 1u) * nx) xb_add(&bar[XB_TOPGEN], 1u);
            else XB_SPIN(xb_ld(&bar[XB_TOPGEN]) == tg, bar);
            __builtin_amdgcn_fence(__ATOMIC_ACQUIRE, "agent");
            xb_add(&bar[XB_XGEN(b.x)], 1u);
            asm volatile("s_waitcnt vmcnt(0)" ::: "memory");
        } else {
            XB_SPIN(xb_ld(&bar[XB_XGEN(b.x)]) == gen, bar);
            __builtin_amdgcn_fence(__ATOMIC_ACQUIRE, "agent");
            asm volatile("s_waitcnt vmcnt(0)" ::: "memory");
        }
    }
    __syncthreads();
}

DI f32x4 bf4(v2u raw) { return (f32x4){bf2f((unsigned short)(raw.x & 0xffffu)), bf2f((unsigned short)(raw.x >> 16)), bf2f((unsigned short)(raw.y & 0xffffu)), bf2f((unsigned short)(raw.y >> 16))}; }
template <bool HAS_MIX, bool WRITE_H, int NR, bool SRC16, bool DST16>
DI void row_pass(const void* xsrc, const bf16* mix, void* xdst, float* rsd, size_t rstride, int rsstride, const float* gpost, int lane) {
    f32x4 v[NR][8]; v2u mr[NR][8];
#pragma unroll
    for (int rr = 0; rr < NR; ++rr) {
        if (SRC16) {
#pragma unroll
            for (int j = 0; j < 8; ++j) { const v2u raw = ((const v2u*)((const bf16*)xsrc + rr * rstride))[lane + 64 * j]; v[rr][j] = bf4(raw); }
        } else {
#pragma unroll
            for (int j = 0; j < 8; ++j) v[rr][j] = __builtin_nontemporal_load((const f32x4*)((const float*)xsrc + rr * rstride) + lane + 64 * j);
        }
        if (HAS_MIX) {
#pragma unroll
            for (int j = 0; j < 8; ++j) mr[rr][j] = __builtin_nontemporal_load((const v2u*)(mix + rr * rstride) + lane + 64 * j); }
    }
    if (!HAS_MIX && DST16) {
#pragma unroll
        for (int rr = 0; rr < NR; ++rr)
#pragma unroll
            for (int j = 0; j < 8; ++j) { v2u w; w.x = pk2(v[rr][j].x, v[rr][j].y); w.y = pk2(v[rr][j].z, v[rr][j].w); ((v2u*)((bf16*)xdst + rr * rstride))[lane + 64 * j] = w; }
    }
    if (HAS_MIX) {
        float rstd[NR];
#pragma unroll
        for (int rr = 0; rr < NR; ++rr) { float ss = 0.f;
#pragma unroll
            for (int j = 0; j < 8; ++j) { const f32x4 m = bf4(mr[rr][j]); ss += (m.x * m.x + m.y * m.y) + (m.z * m.z + m.w * m.w); }
            rstd[rr] = 1.0f / sqrtf(wave_sum(ss) * (1.0f / D) + EPS); }
#pragma unroll
        for (int j = 0; j < 8; ++j) { const f32x4 g = ((const f32x4*)gpost)[lane + 64 * j];
#pragma unroll
            for (int rr = 0; rr < NR; ++rr) { v[rr][j] = v[rr][j] + bf4(mr[rr][j]) * rstd[rr] * g;
                if (DST16) { v2u w; w.x = pk2(v[rr][j].x, v[rr][j].y); w.y = pk2(v[rr][j].z, v[rr][j].w); ((v2u*)((bf16*)xdst + rr * rstride))[lane + 64 * j] = w; }
                else __builtin_nontemporal_store(v[rr][j], (f32x4*)((float*)xdst + rr * rstride) + lane + 64 * j); } }
    }
    if (WRITE_H) {
#pragma unroll
        for (int rr = 0; rr < NR; ++rr) { float ss = 0.f;
#pragma unroll
            for (int j = 0; j < 8; ++j) ss += (v[rr][j].x * v[rr][j].x + v[rr][j].y * v[rr][j].y) + (v[rr][j].z * v[rr][j].z + v[rr][j].w * v[rr][j].w);
            const float rstd = 1.0f / sqrtf(wave_sum(ss) * (1.0f / D) + EPS);
            if (lane == 0) rsd[rr * rsstride] = rstd; }
    }
}

DI void transpose_item(const float* W, int K, int N, bf16* WT, LAS float* scr, int item, int lane, const float* gk) {
    const int nblk = N / 32, kb = item / nblk, nb = item % nblk, k0 = 64 * kb, n0 = 32 * nb;
#pragma unroll
    for (int i = 0; i < 32; ++i) { const int kk = 2 * i + (lane >> 5); const float gv = gk ? gk[k0 + kk] : 1.0f; scr[kk * 33 + (lane & 31)] = __builtin_nontemporal_load(W + (size_t)(k0 + kk) * N + n0 + (lane & 31)) * gv; }
    __builtin_amdgcn_fence(__ATOMIC_RELEASE, "workgroup"); asm volatile("s_waitcnt lgkmcnt(0)" ::: "memory");
    const int c = lane & 7;
#pragma unroll
    for (int j = 0; j < 4; ++j) { const int n = (lane >> 3) + 8 * j; const LAS float* s = scr + (8 * c) * 33 + n;
        v4u o; o.x = pk2(s[0 * 33], s[1 * 33]); o.y = pk2(s[2 * 33], s[3 * 33]); o.z = pk2(s[4 * 33], s[5 * 33]); o.w = pk2(s[6 * 33], s[7 * 33]);
        *(v4u*)(WT + (size_t)(n0 + n) * K + k0 + 8 * c) = o; }
    asm volatile("s_waitcnt lgkmcnt(0)" ::: "memory");
}

DI void prologue(const Params& P, LAS unsigned char* lds) {
    int tid_l = threadIdx.x; asm volatile("" : "+v"(tid_l)); const int tid = tid_l, lane = tid & 63, wave = __builtin_amdgcn_readfirstlane(tid >> 6);
    LAS float* scr = (LAS float*)(lds + wave * 16384);
    const int gw = lbid() * 8 + wave, NGW = lgdim() * 8;
    unsigned char* ws = P.ws;
    constexpr int I0 = 32 * (NIN0 / 32), I1 = 32 * (NIN1 / 32), IO = 32 * 64, IMI = 32 * 256, IMO = 128 * 64, IME = 32 * 32;
    constexpr int NITEMS = I0 + I1 + 2 * IO + 2 * IMI + 2 * IMO + 2 * IME;
    for (int it = gw; it < NITEMS; it += NGW) {
        int q = it;
        if (q < I0) { transpose_item(P.w_in_ret, D, NIN0, (bf16*)(ws + WS_WIN0), scr, q, lane, P.norm_gain); continue; } q -= I0;
        if (q < I1) { transpose_item(P.w_in_na, D, NIN1, (bf16*)(ws + WS_WIN1), scr, q, lane, P.norm_gain + 4 * D); continue; } q -= I1;
        if (q < 2 * IO) { const int i = q / IO; transpose_item(P.w_out + (size_t)i * D * D, D, D, (bf16*)(ws + WS_WOUT) + (size_t)i * D * D, scr, q % IO, lane, nullptr); continue; } q -= 2 * IO;
        if (q < 2 * IMI) { const int i = q / IMI; transpose_item(P.w_mlp_in + (size_t)i * D * DFF, D, DFF, (bf16*)(ws + WS_WMI) + (size_t)i * D * DFF, scr, q % IMI, lane, P.norm_gain + (size_t)i * 4 * D + 2 * D); continue; } q -= 2 * IMI;
        if (q < 2 * IMO) { const int i = q / IMO; transpose_item(P.w_mlp_out + (size_t)i * D * DFF, DFF, D, (bf16*)(ws + WS_WMO) + (size_t)i * D * DFF, scr, q % IMO, lane, nullptr); continue; } q -= 2 * IMO;
        { const int i = q / IME; transpose_item(P.w_mem_kv + (size_t)i * D * 1024, D, 1024, (bf16*)(ws + WS_WMEM) + (size_t)i * D * 1024, scr, q % IME, lane, nullptr); }
    }
    float* rc = (float*)(ws + WS_ROPE); float* rs = rc + 8192 * 64;
    for (int idx = lbid() * 512 + tid; idx < 8192 * 64; idx += lgdim() * 512) {
        const int pos = idx >> 6, i = idx & 63;
        const float inv = powf(10000.0f, -(float)i / 64.0f);
        const float ang = (float)pos * inv;
        rc[idx] = cosf(ang); rs[idx] = sinf(ang);
    }
    bf16* memn = (bf16*)(ws + WS_MEMN);
    for (int row = gw; row < MEMROWS; row += NGW) {
        const float* src = row < 4096 ? P.mem_prompt + (size_t)row * D : P.mem_sample + (size_t)(row - 4096) * D;
        f32x4 v[8]; float ss = 0.f;
#pragma unroll
        for (int j = 0; j < 8; ++j) { v[j] = ((const f32x4*)src)[lane + 64 * j]; ss += (v[j].x * v[j].x + v[j].y * v[j].y) + (v[j].z * v[j].z + v[j].w * v[j].w); }
        const float rstd = 1.0f / sqrtf(wave_sum(ss) * (1.0f / D) + EPS);
#pragma unroll
        for (int i = 0; i < 2; ++i)
#pragma unroll
            for (int j = 0; j < 8; ++j) { const f32x4 g = ((const f32x4*)(P.mem_norm_gain + i * D))[lane + 64 * j]; const f32x4 o = v[j] * rstd * g;
                v2u w; w.x = pk2(o.x, o.y); w.y = pk2(o.z, o.w); ((v2u*)(memn + ((size_t)i * MEMROWS + row) * D))[lane + 64 * j] = w; }
    }
}

DI void phase_rowpass0(const Params& P, int r) {
    int tid_l = threadIdx.x; asm volatile("" : "+v"(tid_l)); const int lane = tid_l & 63, wave = tid_l >> 6;
    bf16* X16 = (bf16*)(P.ws + WS_X16); float* RS = (float*)(P.ws + WS_RSTD); const float* xb = xin_row(P, r * MC);
    const int NGW = lgdim() * 8;
    for (int row = lbid() * 8 + wave; row < MC; row += 2 * NGW) {
        const size_t o = (size_t)row * D;
        if (row + NGW < MC) row_pass<false, true, 2, false, true>(xb + o, nullptr, X16 + o, RS + row, (size_t)NGW * D, NGW, nullptr, lane);
        else row_pass<false, true, 1, false, true>(xb + o, nullptr, X16 + o, RS + row, 0, 0, nullptr, lane);
    }
}
template <bool FINAL>
DI void phase_rowpass(const Params& P, int r, const float* gpost) {
    int tid_l = threadIdx.x; asm volatile("" : "+v"(tid_l)); const int lane = tid_l & 63, wave = tid_l >> 6;
    const bf16* MIX = (const bf16*)(P.ws + WS_MIX); bf16* X16 = (bf16*)(P.ws + WS_X16); float* RS = (float*)(P.ws + WS_RSTD);
    float* xo = P.out + (size_t)r * MC * D;
    const int NGW = lgdim() * 8;
    for (int row = lbid() * 8 + wave; row < MC; row += 2 * NGW) {
        const size_t o = (size_t)row * D;
        void* dst = FINAL ? (void*)(xo + o) : (void*)(X16 + o);
        if (row + NGW < MC) row_pass<true, !FINAL, 2, true, !FINAL>(X16 + o, MIX + o, dst, RS + row, (size_t)NGW * D, NGW, gpost, lane);
        else row_pass<true, !FINAL, 1, true, !FINAL>(X16 + o, MIX + o, dst, RS + row, 0, 0, gpost, lane);
    }
}

DI void run_gemm(LAS unsigned char* lds, const bf16* A, const bf16* Bt, int M, int N, int K, bf16* O, int ldc, int act, int G, int c, const float* rs) {
    pg8::Gemm g{A, Bt, M, N, K}; pg8::StaticOrder S; S.init(M, N, G, c);
    pg8::EpiAct E{O, ldc, act, rs};
    pg8::gemm_phase<pg8::EpiAct, pg8::StaticOrder, true, true>(lds, g, S, E);
}

DI void mem_attn_phase(const Params& P, LAS unsigned char* lds, int r, int layer, const bf16* QKV, int nin, int qoff, bf16* CAT) {
    int tid_l = threadIdx.x; asm volatile("" : "+v"(tid_l)); const int tid = tid_l, lane = tid & 63, wave = __builtin_amdgcn_readfirstlane(tid >> 6), g0 = lane >> 4, li0 = lane & 15;
    const bf16* MEMKV = (const bf16*)(P.ws + WS_MEMKV) + (size_t)layer * MEMROWS * 1024;
    const int L = r < 2 ? 2048 : 8192; const int memrow0 = r < 2 ? r * 8 * 256 : 4096 + (r - 2) * 2 * 256;
    LAS unsigned char* KI = lds; LAS unsigned char* VI = lds + 69632;
    for (int u = lbid(); u < 512; u += lgdim()) {
        int g = g0, li = li0; asm volatile("" : "+v"(g), "+v"(li));
        const int h = u & 3, qt = u >> 2;
        const int s = (qt * 128) / L;
        const bf16* kb = MEMKV + (size_t)(memrow0 + s * 256) * 1024 + h * 128;
        { v4u kreg[8], vreg[8];
        _Pragma("unroll") for (int it_ = 0; it_ < 8; ++it_) { const int task = tid + 512 * it_; const int m = task >> 4, c = task & 15;
            kreg[it_] = *(const v4u*)(kb + (size_t)m * 1024 + c * 8); vreg[it_] = *(const v4u*)(kb + (size_t)m * 1024 + 512 + c * 8); }
        asm volatile("" ::: "memory");
        _Pragma("unroll") for (int it_ = 0; it_ < 8; ++it_) { const int task = tid + 512 * it_; const int m = task >> 4, c = task & 15;
            *(LAS v4u*)(KI + m * PITCH + c * 16) = kreg[it_]; *(LAS v4u*)(VI + m * PITCH + c * 16) = vreg[it_]; } }
        __syncthreads();
        const int row0 = qt * 128 + wave * 16;
        const bf16* qp = QKV + (size_t)(row0 + li) * nin + qoff + h * 128 + 8 * g;
        bf16x8 qa[4];
#pragma unroll
        for (int ks = 0; ks < 4; ++ks) qa[ks] = *(const bf16x8*)(qp + 32 * ks);
        f32x4 sacc[16];
#pragma unroll
        for (int t = 0; t < 16; ++t) { sacc[t] = (f32x4){0.f, 0.f, 0.f, 0.f};
#pragma unroll
            for (int ks = 0; ks < 4; ++ks) sacc[t] = mfma16(qa[ks], frag_row(KI, PITCH, 16 * t, 32 * ks, lane), sacc[t]); }
        float inv[4];
#pragma unroll
        for (int i = 0; i < 4; ++i) { float mx = -INFINITY;
#pragma unroll
            for (int t = 0; t < 16; ++t) mx = fmaxf(mx, sacc[t][i]);
            mx = grp16_max(mx); float sm = 0.f;
#pragma unroll
            for (int t = 0; t < 16; ++t) { const float e = fexp2((sacc[t][i] - mx) * (QK_SCALE * LOG2E)); sacc[t][i] = e; sm += e; }
            inv[i] = 1.0f / grp16_sum(sm); }
        __syncthreads();
#pragma unroll
        for (int t = 0; t < 16; ++t)
#pragma unroll
            for (int i = 0; i < 4; ++i) ((LAS unsigned short*)(KI + (wave * 16 + 4 * g + i) * PPITCH))[16 * t + li] = f2bf(sacc[t][i] * inv[i]);
        __syncthreads();
        f32x4 oacc[8];
#pragma unroll
        for (int t = 0; t < 8; ++t) oacc[t] = (f32x4){0.f, 0.f, 0.f, 0.f};
#pragma unroll
        for (int ks = 0; ks < 8; ++ks) { const bf16x8 pa = frag_row(KI, PPITCH, wave * 16, 32 * ks, lane);
#pragma unroll
            for (int t = 0; t < 8; ++t) oacc[t] = mfma16(pa, frag_tr(VI, PITCH, 32 * ks, 16 * t, lane), oacc[t]); }
#pragma unroll
        for (int t = 0; t < 8; ++t)
#pragma unroll
            for (int i = 0; i < 4; ++i) CAT[(size_t)(row0 + 4 * g + i) * D + 1536 + h * 128 + 16 * t + li] = f2bf(oacc[t][i]);
        __syncthreads();
    }
}

DI void na_phase(const Params& P, LAS unsigned char* lds, int r, const bf16* QKV, bf16* CAT) {
    int tid_l = threadIdx.x; asm volatile("" : "+v"(tid_l)); const int tid = tid_l, lane = tid & 63, wave = __builtin_amdgcn_readfirstlane(tid >> 6), g0 = lane >> 4, li0 = lane & 15;
    const int L = r < 2 ? 2048 : 8192, rows = L / 64;
    constexpr int KVROW = 64 * PITCH;
    LAS unsigned char* PB = lds + 4 * KVROW + wave * 2560;
    LAS float* RB = (LAS float*)(lds + 4 * KVROW + 8 * 2560);
    const int qr = wave >> 1, cbp = (wave & 1) * 2;
    for (int u = lbid(); u < 64 * NTH; u += lgdim()) {
        int g = g0, li = li0; asm volatile("" : "+v"(g), "+v"(li));
        const int h = u % NTH, band = u / NTH;
        const int gr0 = band * 4, s = (gr0 * 64) / L, rin0 = gr0 - s * rows;
        const int rin = rin0 + qr, rs = min(max(rin - 4, 0), rows - 8);
        const int ks0 = min(max(rin0 - 4, 0), rows - 8), nsteps = min(max(rin0 - 1, 0), rows - 8) + 8 - ks0;
        for (int idx = tid; idx < 465; idx += 512) RB[idx] = P.na_rpb[h * 465 + idx];
        bf16x8 qa[2][4];
#pragma unroll
        for (int tl = 0; tl < 2; ++tl) { const bf16* qp = QKV + (size_t)((gr0 + qr) * 64 + (cbp + tl) * 16 + li) * NIN1 + h * 128 + 8 * g;
#pragma unroll
            for (int ks = 0; ks < 4; ++ks) qa[tl][ks] = *(const bf16x8*)(qp + 32 * ks); }
        f32x4 oacc[2][8]; float mrun[2], lrun[2];
#pragma unroll
        for (int tl = 0; tl < 2; ++tl) {
#pragma unroll
            for (int t = 0; t < 8; ++t) oacc[tl][t] = (f32x4){0.f, 0.f, 0.f, 0.f};
            mrun[tl] = -INFINITY; lrun[tl] = 0.f; }
        int dco[2][2][4];
#pragma unroll
        for (int tl = 0; tl < 2; ++tl) { const int cb = cbp + tl, c = cb * 16 + li, wst = min(max(c - 8, 0), 48), blk = min(max(16 * cb - 8, 0), 32);
#pragma unroll
            for (int hf = 0; hf < 2; ++hf)
#pragma unroll
                for (int i = 0; i < 4; ++i) { const int kcol = blk + 16 * hf + 4 * g + i; const bool valid = (kcol >= wst) && (kcol < wst + 16);
                    dco[tl][hf][i] = valid ? min(max(kcol - c + 15, 0), 30) : -1; } }
        const bf16* kvb = QKV + (size_t)((s * rows + ks0) * 64) * NIN1 + 1536 + h * 128;
        const int key0 = tid >> 4, ch = tid & 15;
        const size_t po0 = (size_t)key0 * NIN1 + ch * 8, po1 = po0 + (size_t)32 * NIN1;
        const int lo0 = key0 * PITCH + ch * 16, lo1 = lo0 + 32 * PITCH;
        v4u kr0, kr1, vr0, vr1;
        kr0 = *(const v4u*)(kvb + po0); kr1 = *(const v4u*)(kvb + po1); vr0 = *(const v4u*)(kvb + 1536 + po0); vr1 = *(const v4u*)(kvb + 1536 + po1);
        *(LAS v4u*)(lds + lo0) = kr0; *(LAS v4u*)(lds + lo1) = kr1; *(LAS v4u*)(lds + KVROW + lo0) = vr0; *(LAS v4u*)(lds + KVROW + lo1) = vr1;
        if (nsteps > 1) { const bf16* nb = kvb + (size_t)64 * NIN1;
            kr0 = *(const v4u*)(nb + po0); kr1 = *(const v4u*)(nb + po1); vr0 = *(const v4u*)(nb + 1536 + po0); vr1 = *(const v4u*)(nb + 1536 + po1); }
        __syncthreads();
        for (int k = 0; k < nsteps; ++k) {
            const int kr = ks0 + k;
            const LAS unsigned char* KI = lds + (k & 1) * 2 * KVROW; const LAS unsigned char* VI = KI + KVROW;
            if (kr >= rs && kr < rs + 8) {
                const int dr = kr - rin + 7;
#pragma unroll
                for (int tl = 0; tl < 2; ++tl) {
                    const int cb = cbp + tl, c0 = cb * 16, blk = min(max(16 * cb - 8, 0), 32);
                    f32x4 sc[2];
#pragma unroll
                    for (int hf = 0; hf < 2; ++hf) { sc[hf] = (f32x4){0.f, 0.f, 0.f, 0.f};
#pragma unroll
                        for (int ks = 0; ks < 4; ++ks) sc[hf] = mfma16(frag_row(KI, PITCH, blk + 16 * hf, 32 * ks, lane), qa[tl][ks], sc[hf]); }
                    float mx = -INFINITY; float bvs[2][4];
#pragma unroll
                    for (int hf = 0; hf < 2; ++hf)
#pragma unroll
                        for (int i = 0; i < 4; ++i) bvs[hf][i] = RB[dr * 31 + max(dco[tl][hf][i], 0)];
                    asm volatile("" : "+v"(bvs[0][0]), "+v"(bvs[0][1]), "+v"(bvs[0][2]), "+v"(bvs[0][3]), "+v"(bvs[1][0]), "+v"(bvs[1][1]), "+v"(bvs[1][2]), "+v"(bvs[1][3]));
#pragma unroll
                    for (int hf = 0; hf < 2; ++hf)
#pragma unroll
                        for (int i = 0; i < 4; ++i) { const float sv = dco[tl][hf][i] >= 0 ? sc[hf][i] * QK_SCALE + bvs[hf][i] : -INFINITY; sc[hf][i] = sv; mx = fmaxf(mx, sv); }
                    if (kr == rs) { mx = fmaxf(mx, __shfl_xor(mx, 16)); mx = fmaxf(mx, __shfl_xor(mx, 32)); mrun[tl] = mx; }
                    float ps = 0.f;
#pragma unroll
                    for (int hf = 0; hf < 2; ++hf)
#pragma unroll
                        for (int i = 0; i < 4; ++i) { const float p = fexp2(fminf((sc[hf][i] - mrun[tl]) * LOG2E, 100.0f)); sc[hf][i] = p; ps += p; }
                    lrun[tl] += ps;
                    v4u pw; pw.x = pk2(sc[0][0], sc[0][1]); pw.y = pk2(sc[0][2], sc[0][3]); pw.z = pk2(sc[1][0], sc[1][1]); pw.w = pk2(sc[1][2], sc[1][3]);
                    const bf16x8 pf = __builtin_bit_cast(bf16x8, pw);
#pragma unroll
                    for (int t = 0; t < 8; ++t) oacc[tl][t] = mfma16(frag_tr2(VI, PITCH, blk, blk + 16, 16 * t, lane), pf, oacc[tl][t]);
                }
            }
            if (k + 1 < nsteps) { LAS unsigned char* nk = lds + ((k + 1) & 1) * 2 * KVROW;
                *(LAS v4u*)(nk + lo0) = kr0; *(LAS v4u*)(nk + lo1) = kr1; *(LAS v4u*)(nk + KVROW + lo0) = vr0; *(LAS v4u*)(nk + KVROW + lo1) = vr1;
                if (k + 2 < nsteps) { const bf16* nb = kvb + (size_t)(k + 2) * 64 * NIN1;
                    kr0 = *(const v4u*)(nb + po0); kr1 = *(const v4u*)(nb + po1); vr0 = *(const v4u*)(nb + 1536 + po0); vr1 = *(const v4u*)(nb + 1536 + po1); } }
            __syncthreads();
        }
#pragma unroll
        for (int tl = 0; tl < 2; ++tl) { float lt = lrun[tl]; lt += __shfl_xor(lt, 16); lt += __shfl_xor(lt, 32); const float inv = 1.0f / lt;
            bf16* op = CAT + (size_t)((gr0 + qr) * 64 + (cbp + tl) * 16 + li) * D + h * 128 + 4 * g;
#pragma unroll
            for (int t = 0; t < 8; ++t) { v2u w; w.x = pk2(oacc[tl][t][0] * inv, oacc[tl][t][1] * inv); w.y = pk2(oacc[tl][t][2] * inv, oacc[tl][t][3] * inv); *(v2u*)(op + 16 * t) = w; } }
    }
}

DI float ret_log2gamma(const Params& P, int dir, int h) { const float de = P.ret_decay[dir * NTH + h]; return log1pf(-exp2f(-de)) * LOG2E; }

DI void ret_kv_phase(const Params& P, LAS unsigned char* lds, int r, const bf16* QKV, bf16* ST) {
    int tid_l = threadIdx.x; asm volatile("" : "+v"(tid_l)); const int tid = tid_l, lane = tid & 63, wave = __builtin_amdgcn_readfirstlane(tid >> 6), g0 = lane >> 4, li0 = lane & 15;
    const int L = r < 2 ? 2048 : 8192, cps = L / 128;
    LAS unsigned char* KF = lds; LAS unsigned char* KB = lds + 34816; LAS unsigned char* VI = lds + 69632;
    const float* rc = (const float*)(P.ws + WS_ROPE); const float* rsn = rc + 8192 * 64;
    for (int u = lbid(); u < 128 * NTH; u += lgdim()) {
        int g = g0, li = li0; asm volatile("" : "+v"(g), "+v"(li));
        const int n = u / NTH, h = u % NTH;
        const int tokbase = n * 128, pos0 = (n % cps) * 128;
        const float l2f = ret_log2gamma(P, 0, h), l2b = ret_log2gamma(P, 1, h);
        _Pragma("unroll") for (int it_ = 0; it_ < 2; ++it_) { const int task = tid + 512 * it_; const int j = task >> 3, dg = task & 7;
            const bf16* kp = QKV + (size_t)(tokbase + j) * NIN0 + 1536 + h * 128 + dg * 8;
            const bf16x8 lo = *(const bf16x8*)kp, hi = *(const bf16x8*)(kp + 64);
            const float* cp = rc + (size_t)(pos0 + j) * 64 + dg * 8; const float* sp = rsn + (size_t)(pos0 + j) * 64 + dg * 8;
            const f32x4 c0 = *(const f32x4*)cp, c1 = *(const f32x4*)(cp + 4), s0 = *(const f32x4*)sp, s1 = *(const f32x4*)(sp + 4);
            const float wf = QK_SCALE * fexp2((float)(127 - j) * l2f), wb = QK_SCALE * fexp2((float)j * l2b);
            float o1[8], o2[8];
#pragma unroll
            for (int e = 0; e < 8; ++e) { const float x1 = bf2f((unsigned short)lo[e]), x2 = bf2f((unsigned short)hi[e]); const float c = e < 4 ? c0[e & 3] : c1[e & 3], s = e < 4 ? s0[e & 3] : s1[e & 3];
                o1[e] = x1 * c - x2 * s; o2[e] = x1 * s + x2 * c; }
            v4u a, b, c, d;
            a.x = pk2(o1[0] * wf, o1[1] * wf); a.y = pk2(o1[2] * wf, o1[3] * wf); a.z = pk2(o1[4] * wf, o1[5] * wf); a.w = pk2(o1[6] * wf, o1[7] * wf);
            b.x = pk2(o2[0] * wf, o2[1] * wf); b.y = pk2(o2[2] * wf, o2[3] * wf); b.z = pk2(o2[4] * wf, o2[5] * wf); b.w = pk2(o2[6] * wf, o2[7] * wf);
            c.x = pk2(o1[0] * wb, o1[1] * wb); c.y = pk2(o1[2] * wb, o1[3] * wb); c.z = pk2(o1[4] * wb, o1[5] * wb); c.w = pk2(o1[6] * wb, o1[7] * wb);
            d.x = pk2(o2[0] * wb, o2[1] * wb); d.y = pk2(o2[2] * wb, o2[3] * wb); d.z = pk2(o2[4] * wb, o2[5] * wb); d.w = pk2(o2[6] * wb, o2[7] * wb);
            *(LAS v4u*)(KF + j * PITCH + dg * 16) = a; *(LAS v4u*)(KF + j * PITCH + 128 + dg * 16) = b;
            *(LAS v4u*)(KB + j * PITCH + dg * 16) = c; *(LAS v4u*)(KB + j * PITCH + 128 + dg * 16) = d; }
        _Pragma("unroll") for (int it_ = 0; it_ < 4; ++it_) { const int task = tid + 512 * it_; const int j = task >> 4, c = task & 15;
            *(LAS v4u*)(VI + j * PITCH + c * 16) = *(const v4u*)(QKV + (size_t)(tokbase + j) * NIN0 + 3072 + h * 128 + c * 8); }
        __syncthreads();
        f32x4 af[8], ab[8];
#pragma unroll
        for (int t = 0; t < 8; ++t) { af[t] = (f32x4){0.f, 0.f, 0.f, 0.f}; ab[t] = (f32x4){0.f, 0.f, 0.f, 0.f}; }
#pragma unroll
        for (int ks = 0; ks < 4; ++ks) { const bf16x8 kf = frag_tr(KF, PITCH, 32 * ks, 16 * wave, lane), kb = frag_tr(KB, PITCH, 32 * ks, 16 * wave, lane);
#pragma unroll
            for (int t = 0; t < 8; ++t) { const bf16x8 bv = frag_tr(VI, PITCH, 32 * ks, 16 * t, lane); af[t] = mfma16(bv, kf, af[t]); ab[t] = mfma16(bv, kb, ab[t]); } }
        bf16* sf = ST + ((size_t)(0 * 128 + n) * NTH + h) * 16384; bf16* sb = ST + ((size_t)(1 * 128 + n) * NTH + h) * 16384;
#pragma unroll
        for (int t = 0; t < 8; ++t)
        { const int o = (16 * wave + li) * 128 + 16 * t + 4 * g; v2u wf, wb; wf.x = pk2(af[t][0], af[t][1]); wf.y = pk2(af[t][2], af[t][3]); wb.x = pk2(ab[t][0], ab[t][1]); wb.y = pk2(ab[t][2], ab[t][3]);
            *(v2u*)(sf + o) = wf; *(v2u*)(sb + o) = wb; }
        __syncthreads();
    }
}

DI void ret_scan_phase(const Params& P, int r, bf16* ST) {
    const int L = r < 2 ? 2048 : 8192, cps = L / 128, nseq = MC / L;
    const int ntask = nseq * NTH * 2 * 2048;
    int tid_l = threadIdx.x; asm volatile("" : "+v"(tid_l));
    for (int task = lbid() * 512 + tid_l; task < ntask; task += lgdim() * 512) {
        const int eg = task & 2047; int rest = task >> 11; const int dir = rest & 1; rest >>= 1; const int h = rest % NTH, s = rest / NTH;
        const float decay = exp2f(128.0f * ret_log2gamma(P, dir, h));
        float st[8];
#pragma unroll
        for (int e = 0; e < 8; ++e) st[e] = 0.f;
        for (int step = 0; step < cps; step += 4) {
            v4u kv[4]; bf16* ptr[4];
#pragma unroll
            for (int q = 0; q < 4; ++q) { const int n = dir == 0 ? s * cps + step + q : s * cps + cps - 1 - (step + q);
                ptr[q] = ST + ((size_t)(dir * 128 + n) * NTH + h) * 16384 + eg * 8; kv[q] = *(const v4u*)ptr[q]; }
#pragma unroll
            for (int q = 0; q < 4; ++q) {
                v4u o; o.x = pk2(st[0], st[1]); o.y = pk2(st[2], st[3]); o.z = pk2(st[4], st[5]); o.w = pk2(st[6], st[7]);
                *(v4u*)ptr[q] = o;
                const unsigned w[4] = {kv[q].x, kv[q].y, kv[q].z, kv[q].w};
#pragma unroll
                for (int e = 0; e < 4; ++e) { st[2 * e] = st[2 * e] * decay + bf2f((unsigned short)(w[e] & 0xffffu)); st[2 * e + 1] = st[2 * e + 1] * decay + bf2f((unsigned short)(w[e] >> 16)); }
            }
        }
    }
}

DI void ret_out_phase(const Params& P, LAS unsigned char* lds, int r, const bf16* QKV, const bf16* ST, bf16* CAT) {
    int tid_l = threadIdx.x; asm volatile("" : "+v"(tid_l)); const int tid = tid_l, lane = tid & 63, wave = __builtin_amdgcn_readfirstlane(tid >> 6), g0 = lane >> 4, li0 = lane & 15;
    const int L = r < 2 ? 2048 : 8192, cps = L / 128;
    LAS unsigned char* RA = lds; LAS unsigned char* RB = lds + 34816; LAS unsigned char* RC = lds + 69632; LAS unsigned char* RD = lds + 104448;
    const float* rc = (const float*)(P.ws + WS_ROPE); const float* rsn = rc + 8192 * 64;
    for (int u = lbid(); u < 128 * NTH; u += lgdim()) {
        int g = g0, li = li0; asm volatile("" : "+v"(g), "+v"(li));
        const int n = u / NTH, h = u % NTH;
        const int tokbase = n * 128, pos0 = (n % cps) * 128;
        const float l2f = ret_log2gamma(P, 0, h), l2b = ret_log2gamma(P, 1, h);
        const bf16* stf = ST + ((size_t)(0 * 128 + n) * NTH + h) * 16384; const bf16* stb = ST + ((size_t)(1 * 128 + n) * NTH + h) * 16384;
        _Pragma("unroll") for (int it_ = 0; it_ < 4; ++it_) { const int task = tid + 512 * it_; const int which = task >> 10, j = (task >> 3) & 127, dg = task & 7;
            const bf16* kp = QKV + (size_t)(tokbase + j) * NIN0 + which * 1536 + h * 128 + dg * 8;
            const bf16x8 lo = *(const bf16x8*)kp, hi = *(const bf16x8*)(kp + 64);
            const float* cp = rc + (size_t)(pos0 + j) * 64 + dg * 8; const float* sp = rsn + (size_t)(pos0 + j) * 64 + dg * 8;
            const f32x4 c0 = *(const f32x4*)cp, c1 = *(const f32x4*)(cp + 4), s0 = *(const f32x4*)sp, s1 = *(const f32x4*)(sp + 4);
            const float w = which ? QK_SCALE : 1.0f;
            float o1[8], o2[8];
#pragma unroll
            for (int e = 0; e < 8; ++e) { const float x1 = bf2f((unsigned short)lo[e]), x2 = bf2f((unsigned short)hi[e]); const float c = e < 4 ? c0[e & 3] : c1[e & 3], sn = e < 4 ? s0[e & 3] : s1[e & 3];
                o1[e] = (x1 * c - x2 * sn) * w; o2[e] = (x1 * sn + x2 * c) * w; }
            v4u a, b;
            a.x = pk2(o1[0], o1[1]); a.y = pk2(o1[2], o1[3]); a.z = pk2(o1[4], o1[5]); a.w = pk2(o1[6], o1[7]);
            b.x = pk2(o2[0], o2[1]); b.y = pk2(o2[2], o2[3]); b.z = pk2(o2[4], o2[5]); b.w = pk2(o2[6], o2[7]);
            LAS unsigned char* dst = which ? RB : RA;
            *(LAS v4u*)(dst + j * PITCH + dg * 16) = a; *(LAS v4u*)(dst + j * PITCH + 128 + dg * 16) = b; }
        _Pragma("unroll") for (int it_ = 0; it_ < 4; ++it_) { const int task = tid + 512 * it_; const int j = task >> 4, c = task & 15;
            *(LAS v4u*)(RC + j * PITCH + c * 16) = *(const v4u*)(QKV + (size_t)(tokbase + j) * NIN0 + 3072 + h * 128 + c * 8);
            *(LAS v4u*)(RD + j * PITCH + c * 16) = *(const v4u*)(stf + j * 128 + c * 8); }
        __syncthreads();
        v4u sbr[4];
        _Pragma("unroll") for (int it_ = 0; it_ < 4; ++it_) { const int task = tid + 512 * it_; sbr[it_] = *(const v4u*)(stb + (task >> 4) * 128 + (task & 15) * 8); }
        const size_t tok = (size_t)(tokbase + 16 * wave + li);
        v2u gtv[8];
#pragma unroll
        for (int t = 0; t < 8; ++t) gtv[t] = *(const v2u*)(QKV + tok * NIN0 + 4608 + h * 128 + 16 * t + 4 * g);
        const int itok = 16 * wave + li;
        bf16x8 pf[4];
        {
            f32x4 sacc[8];
#pragma unroll
            for (int t = 0; t < 8; ++t) sacc[t] = (f32x4){0.f, 0.f, 0.f, 0.f};
#pragma unroll
            for (int ks = 0; ks < 4; ++ks) { const bf16x8 qb = frag_row(RA, PITCH, 16 * wave, 32 * ks, lane);
#pragma unroll
                for (int t = 0; t < 8; ++t) sacc[t] = mfma16(frag_row(RB, PITCH, 16 * t, 32 * ks, lane), qb, sacc[t]); }
#pragma unroll
            for (int t = 0; t < 8; ++t)
#pragma unroll
                for (int i = 0; i < 4; ++i) { const int dd = itok - (16 * t + 4 * g + i);
                    sacc[t][i] *= dd >= 0 ? fexp2((float)dd * l2f) : fexp2((float)(-dd) * l2b); }
#pragma unroll
            for (int sx = 0; sx < 4; ++sx) { v4u w; w.x = pk2(sacc[2 * sx][0], sacc[2 * sx][1]); w.y = pk2(sacc[2 * sx][2], sacc[2 * sx][3]);
                w.z = pk2(sacc[2 * sx + 1][0], sacc[2 * sx + 1][1]); w.w = pk2(sacc[2 * sx + 1][2], sacc[2 * sx + 1][3]); pf[sx] = __builtin_bit_cast(bf16x8, w); }
        }
        f32x4 yacc[8];
#pragma unroll
        for (int t = 0; t < 8; ++t) yacc[t] = (f32x4){0.f, 0.f, 0.f, 0.f};
#pragma unroll
        for (int sx = 0; sx < 4; ++sx)
#pragma unroll
            for (int t = 0; t < 8; ++t) yacc[t] = mfma16(frag_tr2(RC, PITCH, 32 * sx, 32 * sx + 16, 16 * t, lane), pf[sx], yacc[t]);
        {
            f32x4 tacc[8];
#pragma unroll
            for (int t = 0; t < 8; ++t) tacc[t] = (f32x4){0.f, 0.f, 0.f, 0.f};
#pragma unroll
            for (int ks = 0; ks < 4; ++ks) { const bf16x8 qb = frag_row(RA, PITCH, 16 * wave, 32 * ks, lane);
#pragma unroll
                for (int t = 0; t < 8; ++t) tacc[t] = mfma16(frag_tr(RD, PITCH, 32 * ks, 16 * t, lane), qb, tacc[t]); }
            const float qd = fexp2((float)(itok + 1) * l2f);
#pragma unroll
            for (int t = 0; t < 8; ++t) yacc[t] = yacc[t] + tacc[t] * qd;
        }
        __syncthreads();
        _Pragma("unroll") for (int it_ = 0; it_ < 4; ++it_) { const int task = tid + 512 * it_; *(LAS v4u*)(RB + (task >> 4) * PITCH + (task & 15) * 16) = sbr[it_]; }
        __syncthreads();
        {
            f32x4 tacc[8];
#pragma unroll
            for (int t = 0; t < 8; ++t) tacc[t] = (f32x4){0.f, 0.f, 0.f, 0.f};
#pragma unroll
            for (int ks = 0; ks < 4; ++ks) { const bf16x8 qb = frag_row(RA, PITCH, 16 * wave, 32 * ks, lane);
#pragma unroll
                for (int t = 0; t < 8; ++t) tacc[t] = mfma16(frag_tr(RB, PITCH, 32 * ks, 16 * t, lane), qb, tacc[t]); }
            const float qd = fexp2((float)(128 - itok) * l2b);
#pragma unroll
            for (int t = 0; t < 8; ++t) yacc[t] = yacc[t] + tacc[t] * qd;
        }
        float ss = 0.f;
#pragma unroll
        for (int t = 0; t < 8; ++t) ss += (yacc[t][0] * yacc[t][0] + yacc[t][1] * yacc[t][1]) + (yacc[t][2] * yacc[t][2] + yacc[t][3] * yacc[t][3]);
        ss += __shfl_xor(ss, 16); ss += __shfl_xor(ss, 32);
        const float rstd = 1.0f / sqrtf(ss * (1.0f / 128.0f) + EPS);
#pragma unroll
        for (int t = 0; t < 8; ++t) { const f32x4 gt = bf4(gtv[t]); f32x4 o;
#pragma unroll
            for (int i = 0; i < 4; ++i) o[i] = gt[i] * __builtin_amdgcn_rcpf(1.0f + fexp2(-gt[i] * LOG2E)) * yacc[t][i] * rstd;
            v2u w; w.x = pk2(o[0], o[1]); w.y = pk2(o[2], o[3]);
            *(v2u*)(CAT + tok * D + h * 128 + 16 * t + 4 * g) = w; }
        __syncthreads();
    }
}

__global__ void __launch_bounds__(512, 2) fwd_kernel(Params P) {
    extern __shared__ __attribute__((aligned(16))) unsigned char lds_raw[];
    LAS unsigned char* lds = (LAS unsigned char*)lds_raw;
    cg::grid_group grid = cg::this_grid();
    volatile LAS unsigned* bst = (volatile LAS unsigned*)(lds + LDS_BYTES - 64);
    if (threadIdx.x < 2) bst[threadIdx.x] = 0u;
    unsigned* barw = (unsigned*)P.ws;
    if (blockIdx.x == 0) for (int i = threadIdx.x; i < XCD_BAR_WORDS; i += 512) __hip_atomic_store(barw + i, 0u, __ATOMIC_RELAXED, __HIP_MEMORY_SCOPE_AGENT);
    prologue(P, lds);
    phase_rowpass0(P, 0);
    __threadfence();
    __syncthreads();
    grid.sync();
    const XcdBarrier xbar = xcd_barrier_post(barw, bst);
    for (int step = 0; step < 1 + 16 * NROUND; ++step) {
        int st = step; asm volatile("" : "+s"(st));
#if defined(__HIP_DEVICE_COMPILE__)
        const __attribute__((address_space(4))) Params* kp = (const __attribute__((address_space(4))) Params*)__builtin_amdgcn_kernarg_segment_ptr();
        asm volatile("" : "+s"(kp));
        Params Q;
        Q.x_prompt = kp->x_prompt; Q.x_sample = kp->x_sample; Q.mem_prompt = kp->mem_prompt; Q.mem_sample = kp->mem_sample; Q.norm_gain = kp->norm_gain; Q.mem_norm_gain = kp->mem_norm_gain;
        Q.w_mem_kv = kp->w_mem_kv; Q.w_out = kp->w_out; Q.w_mlp_in = kp->w_mlp_in; Q.w_mlp_out = kp->w_mlp_out; Q.w_in_ret = kp->w_in_ret; Q.ret_decay = kp->ret_decay;
        Q.w_in_na = kp->w_in_na; Q.na_rpb = kp->na_rpb; Q.out = kp->out; Q.ws = kp->ws;
#else
        Params Q = P;
#endif
        asm volatile("" : "+s"(Q.x_prompt), "+s"(Q.x_sample), "+s"(Q.mem_prompt), "+s"(Q.mem_sample), "+s"(Q.norm_gain), "+s"(Q.mem_norm_gain), "+s"(Q.w_mem_kv), "+s"(Q.w_out));
        asm volatile("" : "+s"(Q.w_mlp_in), "+s"(Q.w_mlp_out), "+s"(Q.w_in_ret), "+s"(Q.ret_decay), "+s"(Q.w_in_na), "+s"(Q.na_rpb), "+s"(Q.out), "+s"(Q.ws));
        unsigned char* ws = Q.ws;
        bf16* H = (bf16*)(ws + WS_X16); const float* RS = (const float*)(ws + WS_RSTD); bf16* QKV = (bf16*)(ws + WS_QKV); bf16* CAT = (bf16*)(ws + WS_CAT); bf16* MIX = (bf16*)(ws + WS_MIX); bf16* ST = (bf16*)(ws + WS_ST);
        const int si = st < 1 ? -1 : (st - 1) & 15, r = st < 1 ? 0 : (st - 1) >> 4;
        const int layer = si >= 9 ? 1 : 0;
        const float* gn = Q.norm_gain + (size_t)layer * 4 * D;
        if (st < 1 || si == 0 || si == 4 || si == 6 || si == 7 || si == 9 || si == 11 || si == 13 || si == 14) {
            const bool split = st < 1 && (gridDim.x & 1) == 0;
            const int nrep = (st < 1 && !split) ? 2 : 1;
            for (int rep = 0; rep < nrep; ++rep) {
                const bf16* A; const bf16* Bt; bf16* O; const float* rs = nullptr; int M = MC, N, K, act = 0, G = (int)gridDim.x, c = (int)blockIdx.x;
                if (st < 1) { const int ml = split ? (int)(blockIdx.x & 1) : rep; if (split) { G >>= 1; c >>= 1; }
                    A = (const bf16*)(ws + WS_MEMN) + (size_t)ml * MEMROWS * D; Bt = (const bf16*)(ws + WS_WMEM) + (size_t)ml * 1024 * D; O = (bf16*)(ws + WS_MEMKV) + (size_t)ml * MEMROWS * 1024; M = MEMROWS; N = 1024; K = D; }
                else if (si == 0) { A = H; rs = RS; Bt = (const bf16*)(ws + WS_WIN0); O = QKV; N = NIN0; K = D; }
                else if (si == 9) { A = H; rs = RS; Bt = (const bf16*)(ws + WS_WIN1); O = QKV; N = NIN1; K = D; }
                else if (si == 4 || si == 11) { A = CAT; Bt = (const bf16*)(ws + WS_WOUT) + (size_t)layer * D * D; O = MIX; N = D; K = D; }
                else if (si == 6 || si == 13) { A = H; rs = RS; Bt = (const bf16*)(ws + WS_WMI) + (size_t)layer * D * DFF; O = QKV; N = DFF; K = D; act = 1; }
                else { A = QKV; Bt = (const bf16*)(ws + WS_WMO) + (size_t)layer * D * DFF; O = MIX; N = D; K = DFF; }
                run_gemm(lds, A, Bt, M, N, K, O, N, act, G, c, rs);
            }
        } else if (si == 1 || si == 10) {
            mem_attn_phase(Q, lds, r, layer, QKV, layer ? NIN1 : NIN0, layer ? 4608 : 6144, CAT);
            if (si == 1) ret_kv_phase(Q, lds, r, QKV, ST); else na_phase(Q, lds, r, QKV, CAT);
        } else if (si == 2) ret_scan_phase(Q, r, ST);
        else if (si == 3) ret_out_phase(Q, lds, r, QKV, ST, CAT);
        else if (si == 5 || si == 8 || si == 12) phase_rowpass<false>(Q, r, (si == 8) ? gn + 3 * D : gn + D);
        else { phase_rowpass<true>(Q, r, gn + 3 * D); if (r + 1 < NROUND) phase_rowpass0(Q, r + 1); }
        if (st + 1 < 1 + 16 * NROUND) { XcdBarrier xb = xbar; asm volatile("" : "+s"(xb.bar), "+s"(xb.x));
            xcd_barrier(xb); }
    }
}

extern "C" void kernel_launch(void* const* d_in, const int* in_sizes, int n_in, void* d_out, int out_size, void* d_ws, size_t ws_size, hipStream_t stream) {
    static int grid = 0;
    if (grid == 0) {
        if (n_in != 14 || ws_size < WS_END) { fprintf(stderr, "kernel_launch: need 14 inputs and >= %zu bytes of workspace; got n_in %d, ws %zu\n", (size_t)WS_END, n_in, ws_size); grid = -1; return; }
        int dev = 0, cus = 0, per_cu = 0;
        (void)hipGetDevice(&dev); (void)hipDeviceGetAttribute(&cus, hipDeviceAttributeMultiprocessorCount, dev);
        if (hipFuncSetAttribute((const void*)fwd_kernel, hipFuncAttributeMaxDynamicSharedMemorySize, LDS_BYTES) != hipSuccess) { fprintf(stderr, "kernel_launch: hipFuncSetAttribute failed\n"); grid = -1; return; }
        if (hipOccupancyMaxActiveBlocksPerMultiprocessor(&per_cu, (const void*)fwd_kernel, 512, LDS_BYTES) != hipSuccess || per_cu < 1) { fprintf(stderr, "kernel_launch: occupancy query says %d blocks per CU\n", per_cu); per_cu = 1; }
        (void)hipGetLastError();
        grid = cus > 0 ? cus : 256;
    }
    if (grid < 0) return;
    Params p{};
    p.x_prompt = (const float*)d_in[0]; p.x_sample = (const float*)d_in[1]; p.mem_prompt = (const float*)d_in[2]; p.mem_sample = (const float*)d_in[3];
    p.norm_gain = (const float*)d_in[4]; p.mem_norm_gain = (const float*)d_in[5]; p.w_mem_kv = (const float*)d_in[6]; p.w_out = (const float*)d_in[7];
    p.w_mlp_in = (const float*)d_in[8]; p.w_mlp_out = (const float*)d_in[9]; p.w_in_ret = (const float*)d_in[10]; p.ret_decay = (const float*)d_in[11];
    p.w_in_na = (const float*)d_in[12]; p.na_rpb = (const float*)d_in[13];
    p.out = (float*)d_out; p.ws = (unsigned char*)d_ws;
    void* args[] = {&p};
    const hipError_t e = hipLaunchCooperativeKernel((const void*)fwd_kernel, dim3(grid), dim3(512), args, LDS_BYTES, stream);
    if (e != hipSuccess) fprintf(stderr, "kernel_launch: cooperative launch failed: %s (grid %d)\n", hipGetErrorString(e), grid);
}
```

```cpp
#include <hip/hip_runtime.h>
#include <hip/hip_cooperative_groups.h>
#include <cstdio>
#include <cstdint>
namespace cg = cooperative_groups;
namespace pg8 {
#define PG8_LAS __attribute__((address_space(3)))
typedef unsigned short bf16_t;
typedef short bf16x8 __attribute__((ext_vector_type(8)));
typedef float f32x4 __attribute__((ext_vector_type(4)));
typedef unsigned u32x4 __attribute__((ext_vector_type(4)));
constexpr int BM = 256, BK = 64, HALF = 128, HTB = HALF * BK * 2  , STAGE_BYTES = 8 * HTB, NXCD = 8, WGM = 4;

__host__ __device__ __forceinline__ int lds_byte(int r, int c) { const int st = (r >> 4) * 2 + (c >> 5), rr = r & 15, cc = c & 31, ob = rr * 64 + cc * 2; return st * 1024 + (ob ^ (((ob >> 9) & 1) << 5)); }
__host__ __device__ __forceinline__ void stage_rc(int b, int& R, int& C) { const int st = b / 1024, sb = b % 1024, swz = sb ^ (((sb >> 9) & 1) << 5); R = (st >> 1) * 16 + swz / 64; C = (st & 1) * 32 + (swz % 64) / 2; }
__host__ __device__ __forceinline__ int perm32(int rho) { const int n = rho >> 4, i = rho & 15; return 8 * (i >> 2) + 4 * n + (i & 3); }

struct Unit { int pm, pn; };
struct Gemm { const bf16_t* A; const bf16_t* Bt; int M, N, K; };

struct StaticOrder {
    int nM, nN, nwg, G, c;
    __host__ __device__ void init(int M, int N, int G_, int c_) { nM = M / BM; nN = N / BM; nwg = nM * nN; G = G_; c = c_; }
    __host__ __device__ bool next(int i, Unit& u) const {
        const long L = (long)i * G + c; if (L >= nwg) return false;
        int wgid = (int)L; { const int q = nwg / NXCD, r = nwg % NXCD, xcd = wgid % NXCD, off = wgid / NXCD; wgid = (xcd < r ? xcd * (q + 1) : r * (q + 1) + (xcd - r) * q) + off; }
        const int nig = WGM * nN, gid = wgid / nig, fm = gid * WGM, gsz = (nM - fm) < WGM ? (nM - fm) : WGM;
        u.pm = fm + ((wgid % nig) % gsz); u.pn = (wgid % nig) / gsz; return true;
    }
    __device__ __forceinline__ void a_ready(const Unit&) const {}
    __device__ __forceinline__ void done(const Unit&) const {}
};

__device__ __forceinline__ unsigned cvt_pk_bf16(float lo, float hi) { unsigned r; asm volatile("v_cvt_pk_bf16_f32 %0, %1, %2" : "=v"(r) : "v"(lo), "v"(hi)); return r; }
struct EpiAct {
    static constexpr bool PERM = true, AFTER_DRAIN = false;
    bf16_t* O; int ldc; int act; const float* rs;
    __device__ __forceinline__ void operator()(const f32x4 (&acc)[2][2][4][2], const Unit& u, int wr, int wc, int fr, int fq) const {
        const int row0 = u.pm * BM + wr * 64 + fr; const int col0 = u.pn * BM + wc * 32 + 8 * fq;
#pragma unroll
        for (int ai = 0; ai < 2; ++ai)
#pragma unroll
            for (int m = 0; m < 4; ++m) { const int row = row0 + ai * HALF + m * 16; bf16_t* rowp = O + (size_t)row * ldc + col0;
                const float sc = rs ? rs[row] : 1.0f;
#pragma unroll
                for (int bj = 0; bj < 2; ++bj) { f32x4 v0 = acc[ai][bj][m][0] * sc, v1 = acc[ai][bj][m][1] * sc;
                    if (act) {
#pragma unroll
                        for (int j = 0; j < 4; ++j) { const float a = fmaxf(v0[j], 0.f), b = fmaxf(v1[j], 0.f); v0[j] = a * a; v1[j] = b * b; } }
                    u32x4 w; w.x = cvt_pk_bf16(v0[0], v0[1]); w.y = cvt_pk_bf16(v0[2], v0[3]); w.z = cvt_pk_bf16(v1[0], v1[1]); w.w = cvt_pk_bf16(v1[2], v1[3]);
                    *(u32x4*)(rowp + bj * HALF) = w; } }
    }
};
template <class Epi, class Sched, bool ALIGN_EPI = false, bool SP2 = false>
__device__ __forceinline__ void gemm_phase(PG8_LAS unsigned char* lds, const Gemm g, const Sched& S, const Epi& E) {
    int tid_l = threadIdx.x; asm volatile("" : "+v"(tid_l)); const int tid = tid_l, wid = __builtin_amdgcn_readfirstlane(tid >> 6), lane = tid & 63, wr = wid >> 2, wc = wid & 3, fr = lane & 15, fq = lane >> 4;
    const int K = g.K, nt = K / BK;
    unsigned voffA[2], voffB[2];
#pragma unroll
    for (int i = 0; i < 2; ++i) { int R, C; stage_rc(tid * 16 + i * 8192, R, C); const int Rb = Epi::PERM ? ((R & ~31) + perm32(R & 31)) : R;
        voffA[i] = (unsigned)(R * K + C) * 2u; voffB[i] = (unsigned)(Rb * K + C) * 2u; }
    const size_t kstep = (size_t)(BK * 2);
    const size_t hstep = (size_t)HALF * K * 2;
    const size_t tstep = 2 * hstep;
    const unsigned ldsw = (unsigned)wid * 1024u;
    const int aoff = lds_byte(wr * 64 + fr, fq * 8), boff = lds_byte(wc * 32 + fr, fq * 8);
#define PG8_SA(b, h) (((b) * 2 + (h)) * HTB)
#define PG8_SB(b, h) ((4 + (b) * 2 + (h)) * HTB)
#define PG8_STAGE(bufoff, gbase, voff) do { _Pragma("unroll") for (int _i = 0; _i < 2; ++_i) \
        __builtin_amdgcn_global_load_lds((const unsigned*)((const char*)(gbase) + (voff)[_i]), (PG8_LAS unsigned*)(lds + (bufoff) + ldsw + _i * 8192), 16, 0, 0); } while (0)
#define PG8_LDA(dst, b, h) do { _Pragma("unroll") for (int m = 0; m < 4; ++m) _Pragma("unroll") for (int k = 0; k < 2; ++k) dst[m][k] = *(const PG8_LAS bf16x8*)(lds + PG8_SA(b, h) + aoff + m * 2048 + k * 1024); } while (0)
#define PG8_LDB(dst, b, h) do { _Pragma("unroll") for (int n = 0; n < 2; ++n) _Pragma("unroll") for (int k = 0; k < 2; ++k) dst[n][k] = *(const PG8_LAS bf16x8*)(lds + PG8_SB(b, h) + boff + n * 2048 + k * 1024); } while (0)
#define PG8_MMA(ai, bj, At, Bt) do { __builtin_amdgcn_s_setprio(1); _Pragma("unroll") for (int m = 0; m < 4; ++m) _Pragma("unroll") for (int n = 0; n < 2; ++n) _Pragma("unroll") for (int k = 0; k < 2; ++k) \
        acc[ai][bj][m][n] = __builtin_amdgcn_mfma_f32_16x16x32_bf16(Bt[n][k], At[m][k], acc[ai][bj][m][n], 0, 0, 0); __builtin_amdgcn_s_setprio(0); } while (0)
#define PG8_WAIT_V(n) asm volatile("s_waitcnt vmcnt(" #n ")" ::: "memory")
#define PG8_WAIT_L(n) asm volatile("s_waitcnt lgkmcnt(" #n ")" ::: "memory")
#define PG8_BAR __builtin_amdgcn_s_barrier()
#define PG8_SCHED __builtin_amdgcn_sched_barrier(0)
    Unit cur, nxt; int ui = 0;
    if (!S.next(0, cur)) return;
    f32x4 acc[2][2][4][2];
#pragma unroll
    for (int a = 0; a < 2; ++a)
#pragma unroll
        for (int b = 0; b < 2; ++b)
#pragma unroll
            for (int m = 0; m < 4; ++m)
#pragma unroll
                for (int n = 0; n < 2; ++n) acc[a][b][m][n] = (f32x4){0.f, 0.f, 0.f, 0.f};
    bf16x8 At[4][2], B0[2][2], B1[2][2];
    const char* cA = (const char*)g.A + (size_t)cur.pm * tstep; const char* cB = (const char*)g.Bt + (size_t)cur.pn * tstep;
    S.a_ready(cur);
    if constexpr (SP2) {
        PG8_STAGE(PG8_SB(0, 0), cB, voffB); PG8_STAGE(PG8_SB(0, 1), cB + hstep, voffB); PG8_STAGE(PG8_SA(0, 0), cA, voffA); PG8_STAGE(PG8_SA(0, 1), cA + hstep, voffA);
        if (wr == 1) PG8_BAR;
        PG8_WAIT_V(2); PG8_BAR;
        PG8_STAGE(PG8_SB(1, 0), cB + kstep, voffB); PG8_STAGE(PG8_SA(1, 0), cA + kstep, voffA); PG8_STAGE(PG8_SB(1, 1), cB + hstep + kstep, voffB);
        PG8_WAIT_V(6); PG8_BAR;
    } else {
        PG8_STAGE(PG8_SB(0, 0), cB, voffB); PG8_STAGE(PG8_SA(0, 0), cA, voffA); PG8_STAGE(PG8_SB(0, 1), cB + hstep, voffB); PG8_STAGE(PG8_SA(0, 1), cA + hstep, voffA);
        if (wr == 1) PG8_BAR;
        PG8_WAIT_V(4); PG8_BAR;
        PG8_STAGE(PG8_SB(1, 0), cB + kstep, voffB); PG8_STAGE(PG8_SA(1, 0), cA + kstep, voffA); PG8_STAGE(PG8_SB(1, 1), cB + hstep + kstep, voffB);
        PG8_WAIT_V(6); PG8_BAR;
    }
    for (;;) {
        const bool has_next = S.next(ui + 1, nxt);
        const char* nA = has_next ? (const char*)g.A + (size_t)nxt.pm * tstep : cA; const char* nB = has_next ? (const char*)g.Bt + (size_t)nxt.pn * tstep : cB;
        for (int t = 0; t < nt; t += 2) {
            const bool last = (t == nt - 2);
            const char* a1 = cA + (size_t)(t + 1) * kstep;
            const char* a2 = last ? nA : cA + (size_t)(t + 2) * kstep; const char* b2 = last ? nB : cB + (size_t)(t + 2) * kstep;
            const char* a3 = a2 + kstep; const char* b3 = b2 + kstep;
            if (last && has_next) S.a_ready(nxt);
            if constexpr (SP2) {
            PG8_LDB(B0, 0, 0); PG8_LDB(B1, 0, 1); PG8_SCHED; PG8_LDA(At, 0, 0); PG8_STAGE(PG8_SA(1, 1), a1 + hstep, voffA);
            PG8_WAIT_V(8); PG8_WAIT_L(0); PG8_BAR; PG8_MMA(0, 0, At, B0); PG8_MMA(0, 1, At, B1); PG8_BAR; PG8_SCHED;
            PG8_LDA(At, 0, 1); PG8_STAGE(PG8_SB(0, 0), b2, voffB); PG8_STAGE(PG8_SB(0, 1), b2 + hstep, voffB); PG8_STAGE(PG8_SA(0, 0), a2, voffA);
            PG8_WAIT_V(8); PG8_WAIT_L(0); PG8_BAR; PG8_MMA(1, 0, At, B0); PG8_MMA(1, 1, At, B1); PG8_BAR; PG8_SCHED;
            PG8_LDB(B0, 1, 0); PG8_LDB(B1, 1, 1); PG8_SCHED; PG8_LDA(At, 1, 0); PG8_STAGE(PG8_SA(0, 1), a2 + hstep, voffA);
            PG8_WAIT_V(8); PG8_WAIT_L(0); PG8_BAR; PG8_MMA(0, 0, At, B0); PG8_MMA(0, 1, At, B1); PG8_BAR; PG8_SCHED;
            PG8_LDA(At, 1, 1); PG8_STAGE(PG8_SB(1, 0), b3, voffB); PG8_STAGE(PG8_SB(1, 1), b3 + hstep, voffB); PG8_STAGE(PG8_SA(1, 0), a3, voffA);
            PG8_WAIT_V(8); PG8_WAIT_L(0); PG8_BAR; PG8_MMA(1, 0, At, B0); PG8_MMA(1, 1, At, B1); PG8_BAR; PG8_SCHED;
            } else {
            PG8_LDB(B0, 0, 0); PG8_SCHED; PG8_LDA(At, 0, 0); PG8_STAGE(PG8_SA(1, 1), a1 + hstep, voffA);
            PG8_WAIT_L(8); PG8_BAR; PG8_WAIT_L(0); PG8_MMA(0, 0, At, B0); PG8_BAR; PG8_SCHED;
            PG8_LDB(B1, 0, 1); PG8_STAGE(PG8_SB(0, 0), b2, voffB);
            PG8_BAR; PG8_WAIT_L(0); PG8_MMA(0, 1, At, B1); PG8_BAR;
            PG8_LDA(At, 0, 1); PG8_STAGE(PG8_SA(0, 0), a2, voffA);
            PG8_BAR; PG8_WAIT_L(0); PG8_MMA(1, 0, At, B0); PG8_BAR; PG8_SCHED;
            PG8_STAGE(PG8_SB(0, 1), b2 + hstep, voffB);
            PG8_WAIT_V(6); PG8_BAR; PG8_MMA(1, 1, At, B1); PG8_BAR;
            PG8_LDB(B0, 1, 0); PG8_SCHED; PG8_LDA(At, 1, 0); PG8_STAGE(PG8_SA(0, 1), a2 + hstep, voffA);
            PG8_WAIT_L(8); PG8_BAR; PG8_WAIT_L(0); PG8_MMA(0, 0, At, B0); PG8_BAR; PG8_SCHED;
            PG8_LDB(B1, 1, 1); PG8_STAGE(PG8_SB(1, 0), b3, voffB);
            PG8_BAR; PG8_WAIT_L(0); PG8_MMA(0, 1, At, B1); PG8_BAR;
            PG8_LDA(At, 1, 1); PG8_STAGE(PG8_SA(1, 0), a3, voffA);
            PG8_BAR; PG8_WAIT_L(0); PG8_MMA(1, 0, At, B0); PG8_BAR; PG8_SCHED;
            PG8_STAGE(PG8_SB(1, 1), b3 + hstep, voffB);
            PG8_WAIT_V(6); PG8_BAR; PG8_MMA(1, 1, At, B1); PG8_BAR;
            }
        }
        if constexpr (ALIGN_EPI) { if (wr == 0) PG8_BAR; }
        if constexpr (!Epi::AFTER_DRAIN) { E(acc, cur, wr, wc, fr, fq); S.done(cur); }
        if (!has_next) break;
#pragma unroll
        for (int a = 0; a < 2; ++a)
#pragma unroll
            for (int b = 0; b < 2; ++b)
#pragma unroll
                for (int m = 0; m < 4; ++m)
#pragma unroll
                    for (int n = 0; n < 2; ++n) acc[a][b][m][n] = (f32x4){0.f, 0.f, 0.f, 0.f};
        cur = nxt; cA = nA; cB = nB; ++ui;
        if constexpr (ALIGN_EPI) { if (wr == 1) PG8_BAR; }
    }
    PG8_WAIT_V(0);
    if constexpr (!ALIGN_EPI) { if (wr == 0) PG8_BAR; }
    PG8_BAR;
    if constexpr (Epi::AFTER_DRAIN) { E.fused(acc, cur, wr, wc, fr, fq, lds, wid, lane); S.done(cur); }
#undef PG8_SA
#undef PG8_SB
#undef PG8_STAGE
#undef PG8_LDA
#undef PG8_LDB
#undef PG8_MMA
#undef PG8_WAIT_V
#undef PG8_WAIT_L
#undef PG8_BAR
#undef PG8_SCHED
}
}
#define LAS __attribute__((address_space(3)))
#define DI __device__ __forceinline__
typedef unsigned short bf16;
typedef short bf16x8 __attribute__((ext_vector_type(8)));
typedef short s16x4 __attribute__((ext_vector_type(4)));
typedef float f32x4 __attribute__((ext_vector_type(4)));
typedef unsigned v4u __attribute__((ext_vector_type(4)));
typedef unsigned v2u __attribute__((ext_vector_type(2)));

constexpr int D = 2048, MC = 16384, NROUND = 4;
constexpr int NIN0 = 6656, NIN1 = 5120, DFF = 8192, NTH = 12;
constexpr int MEMROWS = 5120;
constexpr float EPS = 1e-6f;
constexpr int LDS_BYTES = 147456;
constexpr int PITCH = 272;
constexpr int PPITCH = 528;
constexpr float QK_SCALE = 0.08838834764831845f;
constexpr float LOG2E = 1.4426950408889634f;

constexpr size_t MiB = 1u << 20;
constexpr size_t WS_RSTD = 65536;
constexpr size_t WS_WIN0 = 1 * MiB;
constexpr size_t WS_WIN1 = WS_WIN0 + (size_t)NIN0 * D * 2;
constexpr size_t WS_WOUT = WS_WIN1 + (size_t)NIN1 * D * 2;
constexpr size_t WS_WMI = WS_WOUT + 2 * (size_t)D * D * 2;
constexpr size_t WS_WMO = WS_WMI + 2 * (size_t)DFF * D * 2;
constexpr size_t WS_WMEM = WS_WMO + 2 * (size_t)DFF * D * 2;
constexpr size_t WS_MEMN = WS_WMEM + 2 * (size_t)1024 * D * 2;
constexpr size_t WS_MEMKV = WS_MEMN + 2 * (size_t)MEMROWS * D * 2;
constexpr size_t WS_ROPE = WS_MEMKV + 2 * (size_t)MEMROWS * 1024 * 2;
constexpr size_t WS_H = WS_ROPE + 2 * (size_t)8192 * 64 * 4;
constexpr size_t WS_QKV = WS_H + (size_t)MC * D * 2;
constexpr size_t WS_CAT = WS_QKV + (size_t)MC * DFF * 2;
constexpr size_t WS_MIX = WS_CAT + (size_t)MC * D * 2;
constexpr size_t WS_ST = WS_MIX + (size_t)MC * D * 2;
constexpr size_t WS_X16 = WS_ST + 2 * (size_t)128 * 12 * 16384 * 2;
constexpr size_t WS_END = WS_X16 + (size_t)MC * D * 2;

struct Params {
    const float *x_prompt, *x_sample, *mem_prompt, *mem_sample, *norm_gain, *mem_norm_gain, *w_mem_kv, *w_out, *w_mlp_in, *w_mlp_out, *w_in_ret, *ret_decay, *w_in_na, *na_rpb;
    float* out; unsigned char* ws;
};

DI float bf2f(unsigned short b) { return __builtin_bit_cast(float, (unsigned)b << 16); }
DI unsigned short f2bf_sw(float f) { unsigned u = __builtin_bit_cast(unsigned, f); return (unsigned short)((u + 0x7fffu + ((u >> 16) & 1u)) >> 16); }
DI unsigned pk2(float lo, float hi) { return pg8::cvt_pk_bf16(lo, hi); }
DI unsigned short f2bf(float f) { return (unsigned short)(pg8::cvt_pk_bf16(f, f) & 0xffffu); }
DI float fexp2(float x) { return __builtin_amdgcn_exp2f(x); }
DI float wave_sum(float v) {
#pragma unroll
    for (int o = 1; o < 64; o <<= 1) v += __shfl_xor(v, o);
    return v;
}
DI int lbid() { int b = (int)blockIdx.x; asm volatile("" : "+s"(b)); return b; }
DI int lgdim() { int g = (int)gridDim.x; asm volatile("" : "+s"(g)); return g; }
DI float grp16_sum(float v) { v += __shfl_xor(v, 1); v += __shfl_xor(v, 2); v += __shfl_xor(v, 4); v += __shfl_xor(v, 8); return v; }
DI float grp16_max(float v) { v = fmaxf(v, __shfl_xor(v, 1)); v = fmaxf(v, __shfl_xor(v, 2)); v = fmaxf(v, __shfl_xor(v, 4)); v = fmaxf(v, __shfl_xor(v, 8)); return v; }
DI f32x4 mfma16(bf16x8 a, bf16x8 b, f32x4 c) { return __builtin_amdgcn_mfma_f32_16x16x32_bf16(a, b, c, 0, 0, 0); }
DI bf16x8 frag_row(const LAS unsigned char* img, int pitch, int r0, int k0, int lane) {
    return *(const LAS bf16x8*)(img + (r0 + (lane & 15)) * pitch + (k0 + 8 * (lane >> 4)) * 2);
}
DI bf16x8 frag_tr(const LAS unsigned char* img, int pitch, int k0, int c0, int lane) {
    const int g = lane >> 4, q = (lane & 15) >> 2, p = lane & 3;
    const LAS unsigned char* a = img + (k0 + 8 * g + q) * pitch + (c0 + 4 * p) * 2;
    const s16x4 lo = __builtin_amdgcn_ds_read_tr16_b64_v4i16((LAS s16x4*)a);
    const s16x4 hi = __builtin_amdgcn_ds_read_tr16_b64_v4i16((LAS s16x4*)(a + 4 * pitch));
    return __builtin_shufflevector(lo, hi, 0, 1, 2, 3, 4, 5, 6, 7);
}
DI bf16x8 frag_tr2(const LAS unsigned char* img, int pitch, int rb0, int rb1, int c0, int lane) {
    const int g = lane >> 4, q = (lane & 15) >> 2, p = lane & 3;
    const s16x4 lo = __builtin_amdgcn_ds_read_tr16_b64_v4i16((LAS s16x4*)(img + (rb0 + 4 * g + q) * pitch + (c0 + 4 * p) * 2));
    const s16x4 hi = __builtin_amdgcn_ds_read_tr16_b64_v4i16((LAS s16x4*)(img + (rb1 + 4 * g + q) * pitch + (c0 + 4 * p) * 2));
    return __builtin_shufflevector(lo, hi, 0, 1, 2, 3, 4, 5, 6, 7);
}
DI const float* xin_row(const Params& P, int t) { return t < 32768 ? P.x_prompt + (size_t)t * D : P.x_sample + (size_t)(t - 32768) * D; }

#define XB_TMO      128
#define XB_XCNT(j)  (256  + 64 * (j))
#define XB_XSUB(j)  (1280 + 64 * (j))
#define XB_XGEN(j)  (2304 + 64 * (j))
#define XB_TOP      3328
#define XB_TOPGEN   3392
#define XCD_BAR_WORDS 3456
#define XB_SPIN_CAP (1u << 18)

__device__ __forceinline__ unsigned xb_ld(unsigned* p)              { return __hip_atomic_load(p, __ATOMIC_RELAXED, __HIP_MEMORY_SCOPE_AGENT); }
__device__ __forceinline__ unsigned xb_add(unsigned* p, unsigned v) { return __hip_atomic_fetch_add(p, v, __ATOMIC_RELAXED, __HIP_MEMORY_SCOPE_AGENT); }
__device__ __forceinline__ unsigned xb_xcc_id() { return (unsigned)__builtin_amdgcn_s_getreg((3 << 11) | 20) & 0xFu; }
#define XB_SPIN(cond, bar) do { unsigned _sp = 0; while (cond) { __builtin_amdgcn_s_sleep(1); \
    if ((++_sp & 255u) == 0u) { if (xb_ld(&(bar)[XB_TMO])) break; if (_sp > XB_SPIN_CAP) { atomicAdd(&(bar)[XB_TMO], 1u); break; } } } } while (0)

struct XcdBarrier {
    unsigned* bar; unsigned x;
    volatile LAS unsigned* st;
};

__device__ __forceinline__ XcdBarrier xcd_barrier_post(unsigned* bar, volatile LAS unsigned* st) {
    XcdBarrier b; b.bar = bar; b.x = xb_xcc_id(); b.st = st;
    if (threadIdx.x == 0) (void)xb_add(&bar[XB_XCNT(b.x)], 1u);
    return b;
}
__device__ __forceinline__ void xcd_barrier_complete(unsigned* bar, unsigned x, unsigned& nloc, unsigned& nx) {
    const unsigned G = gridDim.x * gridDim.y * gridDim.z;
    unsigned sum, cnt, mine, sp = 0u;
    for (;;) {
        sum = 0u; cnt = 0u; mine = 0u;
#pragma unroll
        for (unsigned j = 0; j < 16; ++j) { const unsigned c = xb_ld(&bar[XB_XCNT(j)]); sum += c; cnt += (c > 0u) ? 1u : 0u; mine = (j == x) ? c : mine; }
        if (sum == G) break;
        __builtin_amdgcn_s_sleep(1);
        if ((++sp & 255u) == 0u) { if (xb_ld(&bar[XB_TMO])) break; if (sp > XB_SPIN_CAP) { atomicAdd(&bar[XB_TMO], 1u); break; } }
    }
    nloc = mine > 0u ? mine : 1u; nx = cnt > 0u ? cnt : 1u;
}

__device__ __forceinline__ void xcd_barrier(const XcdBarrier& b) {
    asm volatile("s_waitcnt vmcnt(0)" ::: "memory");
    __syncthreads();
    if (threadIdx.x == 0) {
        unsigned* bar = b.bar;
        __builtin_amdgcn_s_waitcnt(0);
        unsigned nloc = b.st[0], nx = b.st[1];
        if (nloc == 0u) { xcd_barrier_complete(bar, b.x, nloc, nx); b.st[0] = nloc; b.st[1] = nx; }
        const unsigned old = xb_add(&bar[XB_XSUB(b.x)], 1u);
        const unsigned gen = old / nloc;
        if (old + 1u == (gen + 1u) * nloc) {
            __builtin_amdgcn_fence(__ATOMIC_RELEASE, "agent");
            asm volatile("s_waitcnt vmcnt(0)" ::: "memory");
            const unsigned og = xb_add(&bar[XB_TOP], 1u);
            const unsigned tg = og / nx;
            if (og + 1u == (tg + 1u) * nx) xb_add(&bar[XB_TOPGEN], 1u);
            else XB_SPIN(xb_ld(&bar[XB_TOPGEN]) == tg, bar);
            __builtin_amdgcn_fence(__ATOMIC_ACQUIRE, "agent");
            xb_add(&bar[XB_XGEN(b.x)], 1u);
            asm volatile("s_waitcnt vmcnt(0)" ::: "memory");
        } else {
            XB_SPIN(xb_ld(&bar[XB_XGEN(b.x)]) == gen, bar);
            __builtin_amdgcn_fence(__ATOMIC_ACQUIRE, "agent");
            asm volatile("s_waitcnt vmcnt(0)" ::: "memory");
        }
    }
    __syncthreads();
}

DI f32x4 bf4(v2u raw) { return (f32x4){bf2f((unsigned short)(raw.x & 0xffffu)), bf2f((unsigned short)(raw.x >> 16)), bf2f((unsigned short)(raw.y & 0xffffu)), bf2f((unsigned short)(raw.y >> 16))}; }
template <bool HAS_MIX, bool WRITE_H, int NR, bool SRC16, bool DST16>
DI void row_pass(const void* xsrc, const bf16* mix, void* xdst, float* rsd, size_t rstride, int rsstride, const float* gpost, int lane) {
    f32x4 v[NR][8]; v2u mr[NR][8];
#pragma unroll
    for (int rr = 0; rr < NR; ++rr) {
        if (SRC16) {
#pragma unroll
            for (int j = 0; j < 8; ++j) { const v2u raw = ((const v2u*)((const bf16*)xsrc + rr * rstride))[lane + 64 * j]; v[rr][j] = bf4(raw); }
        } else {
#pragma unroll
            for (int j = 0; j < 8; ++j) v[rr][j] = __builtin_nontemporal_load((const f32x4*)((const float*)xsrc + rr * rstride) + lane + 64 * j);
        }
        if (HAS_MIX) {
#pragma unroll
            for (int j = 0; j < 8; ++j) mr[rr][j] = __builtin_nontemporal_load((const v2u*)(mix + rr * rstride) + lane + 64 * j); }
    }
    if (!HAS_MIX && DST16) {
#pragma unroll
        for (int rr = 0; rr < NR; ++rr)
#pragma unroll
            for (int j = 0; j < 8; ++j) { v2u w; w.x = pk2(v[rr][j].x, v[rr][j].y); w.y = pk2(v[rr][j].z, v[rr][j].w); ((v2u*)((bf16*)xdst + rr * rstride))[lane + 64 * j] = w; }
    }
    if (HAS_MIX) {
        float rstd[NR];
#pragma unroll
        for (int rr = 0; rr < NR; ++rr) { float ss = 0.f;
#pragma unroll
            for (int j = 0; j < 8; ++j) { const f32x4 m = bf4(mr[rr][j]); ss += (m.x * m.x + m.y * m.y) + (m.z * m.z + m.w * m.w); }
            rstd[rr] = 1.0f / sqrtf(wave_sum(ss) * (1.0f / D) + EPS); }
#pragma unroll
        for (int j = 0; j < 8; ++j) { const f32x4 g = ((const f32x4*)gpost)[lane + 64 * j];
#pragma unroll
            for (int rr = 0; rr < NR; ++rr) { v[rr][j] = v[rr][j] + bf4(mr[rr][j]) * rstd[rr] * g;
                if (DST16) { v2u w; w.x = pk2(v[rr][j].x, v[rr][j].y); w.y = pk2(v[rr][j].z, v[rr][j].w); ((v2u*)((bf16*)xdst + rr * rstride))[lane + 64 * j] = w; }
                else __builtin_nontemporal_store(v[rr][j], (f32x4*)((float*)xdst + rr * rstride) + lane + 64 * j); } }
    }
    if (WRITE_H) {
#pragma unroll
        for (int rr = 0; rr < NR; ++rr) { float ss = 0.f;
#pragma unroll
            for (int j = 0; j < 8; ++j) ss += (v[rr][j].x * v[rr][j].x + v[rr][j].y * v[rr][j].y) + (v[rr][j].z * v[rr][j].z + v[rr][j].w * v[rr][j].w);
            const float rstd = 1.0f / sqrtf(wave_sum(ss) * (1.0f / D) + EPS);
            if (lane == 0) rsd[rr * rsstride] = rstd; }
    }
}

DI void transpose_item(const float* W, int K, int N, bf16* WT, LAS float* scr, int item, int lane, const float* gk) {
    const int nblk = N / 32, kb = item / nblk, nb = item % nblk, k0 = 64 * kb, n0 = 32 * nb;
#pragma unroll
    for (int i = 0; i < 32; ++i) { const int kk = 2 * i + (lane >> 5); const float gv = gk ? gk[k0 + kk] : 1.0f; scr[kk * 33 + (lane & 31)] = __builtin_nontemporal_load(W + (size_t)(k0 + kk) * N + n0 + (lane & 31)) * gv; }
    __builtin_amdgcn_fence(__ATOMIC_RELEASE, "workgroup"); asm volatile("s_waitcnt lgkmcnt(0)" ::: "memory");
    const int c = lane & 7;
#pragma unroll
    for (int j = 0; j < 4; ++j) { const int n = (lane >> 3) + 8 * j; const LAS float* s = scr + (8 * c) * 33 + n;
        v4u o; o.x = pk2(s[0 * 33], s[1 * 33]); o.y = pk2(s[2 * 33], s[3 * 33]); o.z = pk2(s[4 * 33], s[5 * 33]); o.w = pk2(s[6 * 33], s[7 * 33]);
        *(v4u*)(WT + (size_t)(n0 + n) * K + k0 + 8 * c) = o; }
    asm volatile("s_waitcnt lgkmcnt(0)" ::: "memory");
}

DI void prologue(const Params& P, LAS unsigned char* lds) {
    int tid_l = threadIdx.x; asm volatile("" : "+v"(tid_l)); const int tid = tid_l, lane = tid & 63, wave = __builtin_amdgcn_readfirstlane(tid >> 6);
    LAS float* scr = (LAS float*)(lds + wave * 16384);
    const int gw = lbid() * 8 + wave, NGW = lgdim() * 8;
    unsigned char* ws = P.ws;
    constexpr int I0 = 32 * (NIN0 / 32), I1 = 32 * (NIN1 / 32), IO = 32 * 64, IMI = 32 * 256, IMO = 128 * 64, IME = 32 * 32;
    constexpr int NITEMS = I0 + I1 + 2 * IO + 2 * IMI + 2 * IMO + 2 * IME;
    for (int it = gw; it < NITEMS; it += NGW) {
        int q = it;
        if (q < I0) { transpose_item(P.w_in_ret, D, NIN0, (bf16*)(ws + WS_WIN0), scr, q, lane, P.norm_gain); continue; } q -= I0;
        if (q < I1) { transpose_item(P.w_in_na, D, NIN1, (bf16*)(ws + WS_WIN1), scr, q, lane, P.norm_gain + 4 * D); continue; } q -= I1;
        if (q < 2 * IO) { const int i = q / IO; transpose_item(P.w_out + (size_t)i * D * D, D, D, (bf16*)(ws + WS_WOUT) + (size_t)i * D * D, scr, q % IO, lane, nullptr); continue; } q -= 2 * IO;
        if (q < 2 * IMI) { const int i = q / IMI; transpose_item(P.w_mlp_in + (size_t)i * D * DFF, D, DFF, (bf16*)(ws + WS_WMI) + (size_t)i * D * DFF, scr, q % IMI, lane, P.norm_gain + (size_t)i * 4 * D + 2 * D); continue; } q -= 2 * IMI;
        if (q < 2 * IMO) { const int i = q / IMO; transpose_item(P.w_mlp_out + (size_t)i * D * DFF, DFF, D, (bf16*)(ws + WS_WMO) + (size_t)i * D * DFF, scr, q % IMO, lane, nullptr); continue; } q -= 2 * IMO;
        { const int i = q / IME; transpose_item(P.w_mem_kv + (size_t)i * D * 1024, D, 1024, (bf16*)(ws + WS_WMEM) + (size_t)i * D * 1024, scr, q % IME, lane, nullptr); }
    }
    float* rc = (float*)(ws + WS_ROPE); float* rs = rc + 8192 * 64;
    for (int idx = lbid() * 512 + tid; idx < 8192 * 64; idx += lgdim() * 512) {
        const int pos = idx >> 6, i = idx & 63;
        const float inv = powf(10000.0f, -(float)i / 64.0f);
        const float ang = (float)pos * inv;
        rc[idx] = cosf(ang); rs[idx] = sinf(ang);
    }
    bf16* memn = (bf16*)(ws + WS_MEMN);
    for (int row = gw; row < MEMROWS; row += NGW) {
        const float* src = row < 4096 ? P.mem_prompt + (size_t)row * D : P.mem_sample + (size_t)(row - 4096) * D;
        f32x4 v[8]; float ss = 0.f;
#pragma unroll
        for (int j = 0; j < 8; ++j) { v[j] = ((const f32x4*)src)[lane + 64 * j]; ss += (v[j].x * v[j].x + v[j].y * v[j].y) + (v[j].z * v[j].z + v[j].w * v[j].w); }
        const float rstd = 1.0f / sqrtf(wave_sum(ss) * (1.0f / D) + EPS);
#pragma unroll
        for (int i = 0; i < 2; ++i)
#pragma unroll
            for (int j = 0; j < 8; ++j) { const f32x4 g = ((const f32x4*)(P.mem_norm_gain + i * D))[lane + 64 * j]; const f32x4 o = v[j] * rstd * g;
                v2u w; w.x = pk2(o.x, o.y); w.y = pk2(o.z, o.w); ((v2u*)(memn + ((size_t)i * MEMROWS + row) * D))[lane + 64 * j] = w; }
    }
}

DI void phase_rowpass0(const Params& P, int r) {
    int tid_l = threadIdx.x; asm volatile("" : "+v"(tid_l)); const int lane = tid_l & 63, wave = tid_l >> 6;
    bf16* X16 = (bf16*)(P.ws + WS_X16); float* RS = (float*)(P.ws + WS_RSTD); const float* xb = xin_row(P, r * MC);
    const int NGW = lgdim() * 8;
    for (int row = lbid() * 8 + wave; row < MC; row += 2 * NGW) {
        const size_t o = (size_t)row * D;
        if (row + NGW < MC) row_pass<false, true, 2, false, true>(xb + o, nullptr, X16 + o, RS + row, (size_t)NGW * D, NGW, nullptr, lane);
        else row_pass<false, true, 1, false, true>(xb + o, nullptr, X16 + o, RS + row, 0, 0, nullptr, lane);
    }
}
template <bool FINAL>
DI void phase_rowpass(const Params& P, int r, const float* gpost) {
    int tid_l = threadIdx.x; asm volatile("" : "+v"(tid_l)); const int lane = tid_l & 63, wave = tid_l >> 6;
    const bf16* MIX = (const bf16*)(P.ws + WS_MIX); bf16* X16 = (bf16*)(P.ws + WS_X16); float* RS = (float*)(P.ws + WS_RSTD);
    float* xo = P.out + (size_t)r * MC * D;
    const int NGW = lgdim() * 8;
    for (int row = lbid() * 8 + wave; row < MC; row += 2 * NGW) {
        const size_t o = (size_t)row * D;
        void* dst = FINAL ? (void*)(xo + o) : (void*)(X16 + o);
        if (row + NGW < MC) row_pass<true, !FINAL, 2, true, !FINAL>(X16 + o, MIX + o, dst, RS + row, (size_t)NGW * D, NGW, gpost, lane);
        else row_pass<true, !FINAL, 1, true, !FINAL>(X16 + o, MIX + o, dst, RS + row, 0, 0, gpost, lane);
    }
}

DI void run_gemm(LAS unsigned char* lds, const bf16* A, const bf16* Bt, int M, int N, int K, bf16* O, int ldc, int act, int G, int c, const float* rs) {
    pg8::Gemm g{A, Bt, M, N, K}; pg8::StaticOrder S; S.init(M, N, G, c);
    pg8::EpiAct E{O, ldc, act, rs};
    pg8::gemm_phase<pg8::EpiAct, pg8::StaticOrder, true, true>(lds, g, S, E);
}

DI void mem_attn_phase(const Params& P, LAS unsigned char* lds, int r, int layer, const bf16* QKV, int nin, int qoff, bf16* CAT) {
    int tid_l = threadIdx.x; asm volatile("" : "+v"(tid_l)); const int tid = tid_l, lane = tid & 63, wave = __builtin_amdgcn_readfirstlane(tid >> 6), g0 = lane >> 4, li0 = lane & 15;
    const bf16* MEMKV = (const bf16*)(P.ws + WS_MEMKV) + (size_t)layer * MEMROWS * 1024;
    const int L = r < 2 ? 2048 : 8192; const int memrow0 = r < 2 ? r * 8 * 256 : 4096 + (r - 2) * 2 * 256;
    LAS unsigned char* KI = lds; LAS unsigned char* VI = lds + 69632;
    for (int u = lbid(); u < 512; u += lgdim()) {
        int g = g0, li = li0; asm volatile("" : "+v"(g), "+v"(li));
        const int h = u & 3, qt = u >> 2;
        const int s = (qt * 128) / L;
        const bf16* kb = MEMKV + (size_t)(memrow0 + s * 256) * 1024 + h * 128;
        { v4u kreg[8], vreg[8];
        _Pragma("unroll") for (int it_ = 0; it_ < 8; ++it_) { const int task = tid + 512 * it_; const int m = task >> 4, c = task & 15;
            kreg[it_] = *(const v4u*)(kb + (size_t)m * 1024 + c * 8); vreg[it_] = *(const v4u*)(kb + (size_t)m * 1024 + 512 + c * 8); }
        asm volatile("" ::: "memory");
        _Pragma("unroll") for (int it_ = 0; it_ < 8; ++it_) { const int task = tid + 512 * it_; const int m = task >> 4, c = task & 15;
            *(LAS v4u*)(KI + m * PITCH + c * 16) = kreg[it_]; *(LAS v4u*)(VI + m * PITCH + c * 16) = vreg[it_]; } }
        __syncthreads();
        const int row0 = qt * 128 + wave * 16;
        const bf16* qp = QKV + (size_t)(row0 + li) * nin + qoff + h * 128 + 8 * g;
        bf16x8 qa[4];
#pragma unroll
        for (int ks = 0; ks < 4; ++ks) qa[ks] = *(const bf16x8*)(qp + 32 * ks);
        f32x4 sacc[16];
#pragma unroll
        for (int t = 0; t < 16; ++t) sacc[t] = (f32x4){0.f, 0.f, 0.f, 0.f};
#pragma unroll
        for (int tb = 0; tb < 4; ++tb)
#pragma unroll
            for (int ks = 0; ks < 4; ++ks) { bf16x8 kf[4];
#pragma unroll
                for (int t = 0; t < 4; ++t) kf[t] = frag_row(KI, PITCH, 16 * (4 * tb + t), 32 * ks, lane);
                __builtin_amdgcn_sched_barrier(0);
#pragma unroll
                for (int t = 0; t < 4; ++t) sacc[4 * tb + t] = mfma16(qa[ks], kf[t], sacc[4 * tb + t]);
                __builtin_amdgcn_sched_barrier(0); }
        float inv[4];
#pragma unroll
        for (int i = 0; i < 4; ++i) { float mx = -INFINITY;
#pragma unroll
            for (int t = 0; t < 16; ++t) mx = fmaxf(mx, sacc[t][i]);
            mx = grp16_max(mx); float sm = 0.f;
#pragma unroll
            for (int t = 0; t < 16; ++t) { const float e = fexp2((sacc[t][i] - mx) * (QK_SCALE * LOG2E)); sacc[t][i] = e; sm += e; }
            inv[i] = 1.0f / grp16_sum(sm); }
        __syncthreads();
#pragma unroll
        for (int t = 0; t < 16; ++t)
#pragma unroll
            for (int i = 0; i < 4; ++i) ((LAS unsigned short*)(KI + (wave * 16 + 4 * g + i) * PPITCH))[16 * t + li] = f2bf(sacc[t][i] * inv[i]);
        __syncthreads();
        f32x4 oacc[8];
#pragma unroll
        for (int t = 0; t < 8; ++t) oacc[t] = (f32x4){0.f, 0.f, 0.f, 0.f};
#pragma unroll
        for (int ks = 0; ks < 8; ++ks) { const bf16x8 pa = frag_row(KI, PPITCH, wave * 16, 32 * ks, lane);
#pragma unroll
            for (int th = 0; th < 2; ++th) { bf16x8 vf[4];
#pragma unroll
                for (int t = 0; t < 4; ++t) vf[t] = frag_tr(VI, PITCH, 32 * ks, 16 * (4 * th + t), lane);
                __builtin_amdgcn_sched_barrier(0);
#pragma unroll
                for (int t = 0; t < 4; ++t) oacc[4 * th + t] = mfma16(pa, vf[t], oacc[4 * th + t]);
                __builtin_amdgcn_sched_barrier(0); } }
#pragma unroll
        for (int t = 0; t < 8; ++t)
#pragma unroll
            for (int i = 0; i < 4; ++i) CAT[(size_t)(row0 + 4 * g + i) * D + 1536 + h * 128 + 16 * t + li] = f2bf(oacc[t][i]);
        __syncthreads();
    }
}

DI void na_phase(const Params& P, LAS unsigned char* lds, int r, const bf16* QKV, bf16* CAT) {
    int tid_l = threadIdx.x; asm volatile("" : "+v"(tid_l)); const int tid = tid_l, lane = tid & 63, wave = __builtin_amdgcn_readfirstlane(tid >> 6), g0 = lane >> 4, li0 = lane & 15;
    const int L = r < 2 ? 2048 : 8192, rows = L / 64;
    constexpr int KVROW = 64 * PITCH;
    LAS unsigned char* PB = lds + 4 * KVROW + wave * 2560;
    LAS float* RB = (LAS float*)(lds + 4 * KVROW + 8 * 2560);
    const int qr = wave >> 1, cbp = (wave & 1) * 2;
    for (int u = lbid(); u < 64 * NTH; u += lgdim()) {
        int g = g0, li = li0; asm volatile("" : "+v"(g), "+v"(li));
        const int h = u % NTH, band = u / NTH;
        const int gr0 = band * 4, s = (gr0 * 64) / L, rin0 = gr0 - s * rows;
        const int rin = rin0 + qr, rs = min(max(rin - 4, 0), rows - 8);
        const int ks0 = min(max(rin0 - 4, 0), rows - 8), nsteps = min(max(rin0 - 1, 0), rows - 8) + 8 - ks0;
        for (int idx = tid; idx < 465; idx += 512) RB[idx] = P.na_rpb[h * 465 + idx];
        bf16x8 qa[2][4];
#pragma unroll
        for (int tl = 0; tl < 2; ++tl) { const bf16* qp = QKV + (size_t)((gr0 + qr) * 64 + (cbp + tl) * 16 + li) * NIN1 + h * 128 + 8 * g;
#pragma unroll
            for (int ks = 0; ks < 4; ++ks) qa[tl][ks] = *(const bf16x8*)(qp + 32 * ks); }
        f32x4 oacc[2][8]; float mrun[2], lrun[2];
#pragma unroll
        for (int tl = 0; tl < 2; ++tl) {
#pragma unroll
            for (int t = 0; t < 8; ++t) oacc[tl][t] = (f32x4){0.f, 0.f, 0.f, 0.f};
            mrun[tl] = -INFINITY; lrun[tl] = 0.f; }
        int dco[2][2][4];
#pragma unroll
        for (int tl = 0; tl < 2; ++tl) { const int cb = cbp + tl, c = cb * 16 + li, wst = min(max(c - 8, 0), 48), blk = min(max(16 * cb - 8, 0), 32);
#pragma unroll
            for (int hf = 0; hf < 2; ++hf)
#pragma unroll
                for (int i = 0; i < 4; ++i) { const int kcol = blk + 16 * hf + 4 * g + i; const bool valid = (kcol >= wst) && (kcol < wst + 16);
                    dco[tl][hf][i] = valid ? min(max(kcol - c + 15, 0), 30) : -1; } }
        const bf16* kvb = QKV + (size_t)((s * rows + ks0) * 64) * NIN1 + 1536 + h * 128;
        const int key0 = tid >> 4, ch = tid & 15;
        const size_t po0 = (size_t)key0 * NIN1 + ch * 8, po1 = po0 + (size_t)32 * NIN1;
        const int lo0 = key0 * PITCH + ch * 16, lo1 = lo0 + 32 * PITCH;
        v4u kr0, kr1, vr0, vr1;
        kr0 = *(const v4u*)(kvb + po0); kr1 = *(const v4u*)(kvb + po1); vr0 = *(const v4u*)(kvb + 1536 + po0); vr1 = *(const v4u*)(kvb + 1536 + po1);
        *(LAS v4u*)(lds + lo0) = kr0; *(LAS v4u*)(lds + lo1) = kr1; *(LAS v4u*)(lds + KVROW + lo0) = vr0; *(LAS v4u*)(lds + KVROW + lo1) = vr1;
        if (nsteps > 1) { const bf16* nb = kvb + (size_t)64 * NIN1;
            kr0 = *(const v4u*)(nb + po0); kr1 = *(const v4u*)(nb + po1); vr0 = *(const v4u*)(nb + 1536 + po0); vr1 = *(const v4u*)(nb + 1536 + po1); }
        __syncthreads();
        for (int k = 0; k < nsteps; ++k) {
            const int kr = ks0 + k;
            const LAS unsigned char* KI = lds + (k & 1) * 2 * KVROW; const LAS unsigned char* VI = KI + KVROW;
            if (kr >= rs && kr < rs + 8) {
                const int dr = kr - rin + 7;
#pragma unroll
                for (int tl = 0; tl < 2; ++tl) {
                    const int cb = cbp + tl, c0 = cb * 16, blk = min(max(16 * cb - 8, 0), 32);
                    f32x4 sc[2];
#pragma unroll
                    for (int hf = 0; hf < 2; ++hf) { sc[hf] = (f32x4){0.f, 0.f, 0.f, 0.f};
#pragma unroll
                        for (int ks = 0; ks < 4; ++ks) sc[hf] = mfma16(frag_row(KI, PITCH, blk + 16 * hf, 32 * ks, lane), qa[tl][ks], sc[hf]); }
                    float mx = -INFINITY; float bvs[2][4];
#pragma unroll
                    for (int hf = 0; hf < 2; ++hf)
#pragma unroll
                        for (int i = 0; i < 4; ++i) bvs[hf][i] = RB[dr * 31 + max(dco[tl][hf][i], 0)];
                    asm volatile("" : "+v"(bvs[0][0]), "+v"(bvs[0][1]), "+v"(bvs[0][2]), "+v"(bvs[0][3]), "+v"(bvs[1][0]), "+v"(bvs[1][1]), "+v"(bvs[1][2]), "+v"(bvs[1][3]));
#pragma unroll
                    for (int hf = 0; hf < 2; ++hf)
#pragma unroll
                        for (int i = 0; i < 4; ++i) { const float sv = dco[tl][hf][i] >= 0 ? sc[hf][i] * QK_SCALE + bvs[hf][i] : -INFINITY; sc[hf][i] = sv; mx = fmaxf(mx, sv); }
                    if (kr == rs) { mx = fmaxf(mx, __shfl_xor(mx, 16)); mx = fmaxf(mx, __shfl_xor(mx, 32)); mrun[tl] = mx; }
                    float ps = 0.f;
#pragma unroll
                    for (int hf = 0; hf < 2; ++hf)
#pragma unroll
                        for (int i = 0; i < 4; ++i) { const float p = fexp2(fminf((sc[hf][i] - mrun[tl]) * LOG2E, 100.0f)); sc[hf][i] = p; ps += p; }
                    lrun[tl] += ps;
                    v4u pw; pw.x = pk2(sc[0][0], sc[0][1]); pw.y = pk2(sc[0][2], sc[0][3]); pw.z = pk2(sc[1][0], sc[1][1]); pw.w = pk2(sc[1][2], sc[1][3]);
                    const bf16x8 pf = __builtin_bit_cast(bf16x8, pw);
#pragma unroll
                    for (int t = 0; t < 8; ++t) { oacc[tl][t] = mfma16(frag_tr2(VI, PITCH, blk, blk + 16, 16 * t, lane), pf, oacc[tl][t]); if ((t & 3) == 3) __builtin_amdgcn_sched_barrier(0); }
                }
            }
            if (k + 1 < nsteps) { LAS unsigned char* nk = lds + ((k + 1) & 1) * 2 * KVROW;
                *(LAS v4u*)(nk + lo0) = kr0; *(LAS v4u*)(nk + lo1) = kr1; *(LAS v4u*)(nk + KVROW + lo0) = vr0; *(LAS v4u*)(nk + KVROW + lo1) = vr1;
                if (k + 2 < nsteps) { const bf16* nb = kvb + (size_t)(k + 2) * 64 * NIN1;
                    kr0 = *(const v4u*)(nb + po0); kr1 = *(const v4u*)(nb + po1); vr0 = *(const v4u*)(nb + 1536 + po0); vr1 = *(const v4u*)(nb + 1536 + po1); } }
            __syncthreads();
        }
#pragma unroll
        for (int tl = 0; tl < 2; ++tl) { float lt = lrun[tl]; lt += __shfl_xor(lt, 16); lt += __shfl_xor(lt, 32); const float inv = 1.0f / lt;
            bf16* op = CAT + (size_t)((gr0 + qr) * 64 + (cbp + tl) * 16 + li) * D + h * 128 + 4 * g;
#pragma unroll
            for (int t = 0; t < 8; ++t) { v2u w; w.x = pk2(oacc[tl][t][0] * inv, oacc[tl][t][1] * inv); w.y = pk2(oacc[tl][t][2] * inv, oacc[tl][t][3] * inv); *(v2u*)(op + 16 * t) = w; } }
    }
}

DI float ret_log2gamma(const Params& P, int dir, int h) { const float de = P.ret_decay[dir * NTH + h]; return log1pf(-exp2f(-de)) * LOG2E; }

DI void ret_kv_phase(const Params& P, LAS unsigned char* lds, int r, const bf16* QKV, bf16* ST) {
    int tid_l = threadIdx.x; asm volatile("" : "+v"(tid_l)); const int tid = tid_l, lane = tid & 63, wave = __builtin_amdgcn_readfirstlane(tid >> 6), g0 = lane >> 4, li0 = lane & 15;
    const int L = r < 2 ? 2048 : 8192, cps = L / 128;
    LAS unsigned char* KF = lds; LAS unsigned char* KB = lds + 34816; LAS unsigned char* VI = lds + 69632;
    const float* rc = (const float*)(P.ws + WS_ROPE); const float* rsn = rc + 8192 * 64;
    for (int u = lbid(); u < 128 * NTH; u += lgdim()) {
        int g = g0, li = li0; asm volatile("" : "+v"(g), "+v"(li));
        const int n = u / NTH, h = u % NTH;
        const int tokbase = n * 128, pos0 = (n % cps) * 128;
        const float l2f = ret_log2gamma(P, 0, h), l2b = ret_log2gamma(P, 1, h);
        _Pragma("unroll") for (int it_ = 0; it_ < 2; ++it_) { const int task = tid + 512 * it_; const int j = task >> 3, dg = task & 7;
            const bf16* kp = QKV + (size_t)(tokbase + j) * NIN0 + 1536 + h * 128 + dg * 8;
            const bf16x8 lo = *(const bf16x8*)kp, hi = *(const bf16x8*)(kp + 64);
            const float* cp = rc + (size_t)(pos0 + j) * 64 + dg * 8; const float* sp = rsn + (size_t)(pos0 + j) * 64 + dg * 8;
            const f32x4 c0 = *(const f32x4*)cp, c1 = *(const f32x4*)(cp + 4), s0 = *(const f32x4*)sp, s1 = *(const f32x4*)(sp + 4);
            const float wf = QK_SCALE * fexp2((float)(127 - j) * l2f), wb = QK_SCALE * fexp2((float)j * l2b);
            float o1[8], o2[8];
#pragma unroll
            for (int e = 0; e < 8; ++e) { const float x1 = bf2f((unsigned short)lo[e]), x2 = bf2f((unsigned short)hi[e]); const float c = e < 4 ? c0[e & 3] : c1[e & 3], s = e < 4 ? s0[e & 3] : s1[e & 3];
                o1[e] = x1 * c - x2 * s; o2[e] = x1 * s + x2 * c; }
            v4u a, b, c, d;
            a.x = pk2(o1[0] * wf, o1[1] * wf); a.y = pk2(o1[2] * wf, o1[3] * wf); a.z = pk2(o1[4] * wf, o1[5] * wf); a.w = pk2(o1[6] * wf, o1[7] * wf);
            b.x = pk2(o2[0] * wf, o2[1] * wf); b.y = pk2(o2[2] * wf, o2[3] * wf); b.z = pk2(o2[4] * wf, o2[5] * wf); b.w = pk2(o2[6] * wf, o2[7] * wf);
            c.x = pk2(o1[0] * wb, o1[1] * wb); c.y = pk2(o1[2] * wb, o1[3] * wb); c.z = pk2(o1[4] * wb, o1[5] * wb); c.w = pk2(o1[6] * wb, o1[7] * wb);
            d.x = pk2(o2[0] * wb, o2[1] * wb); d.y = pk2(o2[2] * wb, o2[3] * wb); d.z = pk2(o2[4] * wb, o2[5] * wb); d.w = pk2(o2[6] * wb, o2[7] * wb);
            *(LAS v4u*)(KF + j * PITCH + dg * 16) = a; *(LAS v4u*)(KF + j * PITCH + 128 + dg * 16) = b;
            *(LAS v4u*)(KB + j * PITCH + dg * 16) = c; *(LAS v4u*)(KB + j * PITCH + 128 + dg * 16) = d; }
        _Pragma("unroll") for (int it_ = 0; it_ < 4; ++it_) { const int task = tid + 512 * it_; const int j = task >> 4, c = task & 15;
            *(LAS v4u*)(VI + j * PITCH + c * 16) = *(const v4u*)(QKV + (size_t)(tokbase + j) * NIN0 + 3072 + h * 128 + c * 8); }
        __syncthreads();
        f32x4 af[8], ab[8];
#pragma unroll
        for (int t = 0; t < 8; ++t) { af[t] = (f32x4){0.f, 0.f, 0.f, 0.f}; ab[t] = (f32x4){0.f, 0.f, 0.f, 0.f}; }
#pragma unroll
        for (int ks = 0; ks < 4; ++ks) { const bf16x8 kf = frag_tr(KF, PITCH, 32 * ks, 16 * wave, lane), kb = frag_tr(KB, PITCH, 32 * ks, 16 * wave, lane);
#pragma unroll
            for (int t = 0; t < 8; ++t) { if ((t & 3) == 0) __builtin_amdgcn_sched_barrier(0); const bf16x8 bv = frag_tr(VI, PITCH, 32 * ks, 16 * t, lane); af[t] = mfma16(bv, kf, af[t]); ab[t] = mfma16(bv, kb, ab[t]); }
            __builtin_amdgcn_sched_barrier(0); }
        bf16* sf = ST + ((size_t)(0 * 128 + n) * NTH + h) * 16384; bf16* sb = ST + ((size_t)(1 * 128 + n) * NTH + h) * 16384;
#pragma unroll
        for (int t = 0; t < 8; ++t)
        { const int o = (16 * wave + li) * 128 + 16 * t + 4 * g; v2u wf, wb; wf.x = pk2(af[t][0], af[t][1]); wf.y = pk2(af[t][2], af[t][3]); wb.x = pk2(ab[t][0], ab[t][1]); wb.y = pk2(ab[t][2], ab[t][3]);
            *(v2u*)(sf + o) = wf; *(v2u*)(sb + o) = wb; }
        __syncthreads();
    }
}

DI void ret_scan_phase(const Params& P, int r, bf16* ST) {
    const int L = r < 2 ? 2048 : 8192, cps = L / 128, nseq = MC / L;
    const int ntask = nseq * NTH * 2 * 2048;
    int tid_l = threadIdx.x; asm volatile("" : "+v"(tid_l));
    for (int task = lbid() * 512 + tid_l; task < ntask; task += lgdim() * 512) {
        const int eg = task & 2047; int rest = task >> 11; const int dir = rest & 1; rest >>= 1; const int h = rest % NTH, s = rest / NTH;
        const float decay = exp2f(128.0f * ret_log2gamma(P, dir, h));
        float st[8];
#pragma unroll
        for (int e = 0; e < 8; ++e) st[e] = 0.f;
        for (int step = 0; step < cps; step += 4) {
            v4u kv[4]; bf16* ptr[4];
#pragma unroll
            for (int q = 0; q < 4; ++q) { const int n = dir == 0 ? s * cps + step + q : s * cps + cps - 1 - (step + q);
                ptr[q] = ST + ((size_t)(dir * 128 + n) * NTH + h) * 16384 + eg * 8; kv[q] = *(const v4u*)ptr[q]; }
#pragma unroll
            for (int q = 0; q < 4; ++q) {
                v4u o; o.x = pk2(st[0], st[1]); o.y = pk2(st[2], st[3]); o.z = pk2(st[4], st[5]); o.w = pk2(st[6], st[7]);
                *(v4u*)ptr[q] = o;
                const unsigned w[4] = {kv[q].x, kv[q].y, kv[q].z, kv[q].w};
#pragma unroll
                for (int e = 0; e < 4; ++e) { st[2 * e] = st[2 * e] * decay + bf2f((unsigned short)(w[e] & 0xffffu)); st[2 * e + 1] = st[2 * e + 1] * decay + bf2f((unsigned short)(w[e] >> 16)); }
            }
        }
    }
}

DI void ret_out_phase(const Params& P, LAS unsigned char* lds, int r, const bf16* QKV, const bf16* ST, bf16* CAT) {
    int tid_l = threadIdx.x; asm volatile("" : "+v"(tid_l)); const int tid = tid_l, lane = tid & 63, wave = __builtin_amdgcn_readfirstlane(tid >> 6), g0 = lane >> 4, li0 = lane & 15;
    const int L = r < 2 ? 2048 : 8192, cps = L / 128;
    LAS unsigned char* RA = lds; LAS unsigned char* RB = lds + 34816; LAS unsigned char* RC = lds + 69632; LAS unsigned char* RD = lds + 104448;
    const float* rc = (const float*)(P.ws + WS_ROPE); const float* rsn = rc + 8192 * 64;
    for (int u = lbid(); u < 128 * NTH; u += lgdim()) {
        int g = g0, li = li0; asm volatile("" : "+v"(g), "+v"(li));
        const int n = u / NTH, h = u % NTH;
        const int tokbase = n * 128, pos0 = (n % cps) * 128;
        const float l2f = ret_log2gamma(P, 0, h), l2b = ret_log2gamma(P, 1, h);
        const bf16* stf = ST + ((size_t)(0 * 128 + n) * NTH + h) * 16384; const bf16* stb = ST + ((size_t)(1 * 128 + n) * NTH + h) * 16384;
        _Pragma("unroll") for (int it_ = 0; it_ < 4; ++it_) { const int task = tid + 512 * it_; const int which = task >> 10, j = (task >> 3) & 127, dg = task & 7;
            const bf16* kp = QKV + (size_t)(tokbase + j) * NIN0 + which * 1536 + h * 128 + dg * 8;
            const bf16x8 lo = *(const bf16x8*)kp, hi = *(const bf16x8*)(kp + 64);
            const float* cp = rc + (size_t)(pos0 + j) * 64 + dg * 8; const float* sp = rsn + (size_t)(pos0 + j) * 64 + dg * 8;
            const f32x4 c0 = *(const f32x4*)cp, c1 = *(const f32x4*)(cp + 4), s0 = *(const f32x4*)sp, s1 = *(const f32x4*)(sp + 4);
            const float w = which ? QK_SCALE : 1.0f;
            float o1[8], o2[8];
#pragma unroll
            for (int e = 0; e < 8; ++e) { const float x1 = bf2f((unsigned short)lo[e]), x2 = bf2f((unsigned short)hi[e]); const float c = e < 4 ? c0[e & 3] : c1[e & 3], sn = e < 4 ? s0[e & 3] : s1[e & 3];
                o1[e] = (x1 * c - x2 * sn) * w; o2[e] = (x1 * sn + x2 * c) * w; }
            v4u a, b;
            a.x = pk2(o1[0], o1[1]); a.y = pk2(o1[2], o1[3]); a.z = pk2(o1[4], o1[5]); a.w = pk2(o1[6], o1[7]);
            b.x = pk2(o2[0], o2[1]); b.y = pk2(o2[2], o2[3]); b.z = pk2(o2[4], o2[5]); b.w = pk2(o2[6], o2[7]);
            LAS unsigned char* dst = which ? RB : RA;
            *(LAS v4u*)(dst + j * PITCH + dg * 16) = a; *(LAS v4u*)(dst + j * PITCH + 128 + dg * 16) = b; }
        _Pragma("unroll") for (int it_ = 0; it_ < 4; ++it_) { const int task = tid + 512 * it_; const int j = task >> 4, c = task & 15;
            *(LAS v4u*)(RC + j * PITCH + c * 16) = *(const v4u*)(QKV + (size_t)(tokbase + j) * NIN0 + 3072 + h * 128 + c * 8);
            *(LAS v4u*)(RD + j * PITCH + c * 16) = *(const v4u*)(stf + j * 128 + c * 8); }
        __syncthreads();
        v4u sbr[4];
        _Pragma("unroll") for (int it_ = 0; it_ < 4; ++it_) { const int task = tid + 512 * it_; sbr[it_] = *(const v4u*)(stb + (task >> 4) * 128 + (task & 15) * 8); }
        const size_t tok = (size_t)(tokbase + 16 * wave + li);
        v2u gtv[8];
#pragma unroll
        for (int t = 0; t < 8; ++t) gtv[t] = *(const v2u*)(QKV + tok * NIN0 + 4608 + h * 128 + 16 * t + 4 * g);
        const int itok = 16 * wave + li;
        bf16x8 pf[4];
        {
            f32x4 sacc[8];
#pragma unroll
            for (int t = 0; t < 8; ++t) sacc[t] = (f32x4){0.f, 0.f, 0.f, 0.f};
#pragma unroll
            for (int ks = 0; ks < 4; ++ks) { const bf16x8 qb = frag_row(RA, PITCH, 16 * wave, 32 * ks, lane);
#pragma unroll
                for (int t = 0; t < 8; ++t) sacc[t] = mfma16(frag_row(RB, PITCH, 16 * t, 32 * ks, lane), qb, sacc[t]); }
#pragma unroll
            for (int t = 0; t < 8; ++t)
#pragma unroll
                for (int i = 0; i < 4; ++i) { const int dd = itok - (16 * t + 4 * g + i);
                    sacc[t][i] *= dd >= 0 ? fexp2((float)dd * l2f) : fexp2((float)(-dd) * l2b); }
#pragma unroll
            for (int sx = 0; sx < 4; ++sx) { v4u w; w.x = pk2(sacc[2 * sx][0], sacc[2 * sx][1]); w.y = pk2(sacc[2 * sx][2], sacc[2 * sx][3]);
                w.z = pk2(sacc[2 * sx + 1][0], sacc[2 * sx + 1][1]); w.w = pk2(sacc[2 * sx + 1][2], sacc[2 * sx + 1][3]); pf[sx] = __builtin_bit_cast(bf16x8, w); }
        }
        f32x4 yacc[8];
#pragma unroll
        for (int t = 0; t < 8; ++t) yacc[t] = (f32x4){0.f, 0.f, 0.f, 0.f};
#pragma unroll
        for (int sx = 0; sx < 4; ++sx)
#pragma unroll
            for (int t = 0; t < 8; ++t) { yacc[t] = mfma16(frag_tr2(RC, PITCH, 32 * sx, 32 * sx + 16, 16 * t, lane), pf[sx], yacc[t]); if ((t & 3) == 3) __builtin_amdgcn_sched_barrier(0); }
        {
            f32x4 tacc[8];
#pragma unroll
            for (int t = 0; t < 8; ++t) tacc[t] = (f32x4){0.f, 0.f, 0.f, 0.f};
#pragma unroll
            for (int ks = 0; ks < 4; ++ks) { const bf16x8 qb = frag_row(RA, PITCH, 16 * wave, 32 * ks, lane);
#pragma unroll
                for (int t = 0; t < 8; ++t) { tacc[t] = mfma16(frag_tr(RD, PITCH, 32 * ks, 16 * t, lane), qb, tacc[t]); if ((t & 3) == 3) __builtin_amdgcn_sched_barrier(0); } }
            const float qd = fexp2((float)(itok + 1) * l2f);
#pragma unroll
            for (int t = 0; t < 8; ++t) yacc[t] = yacc[t] + tacc[t] * qd;
        }
        __syncthreads();
        _Pragma("unroll") for (int it_ = 0; it_ < 4; ++it_) { const int task = tid + 512 * it_; *(LAS v4u*)(RB + (task >> 4) * PITCH + (task & 15) * 16) = sbr[it_]; }
        __syncthreads();
        {
            f32x4 tacc[8];
#pragma unroll
            for (int t = 0; t < 8; ++t) tacc[t] = (f32x4){0.f, 0.f, 0.f, 0.f};
#pragma unroll
            for (int ks = 0; ks < 4; ++ks) { const bf16x8 qb = frag_row(RA, PITCH, 16 * wave, 32 * ks, lane);
#pragma unroll
                for (int t = 0; t < 8; ++t) { tacc[t] = mfma16(frag_tr(RB, PITCH, 32 * ks, 16 * t, lane), qb, tacc[t]); if ((t & 3) == 3) __builtin_amdgcn_sched_barrier(0); } }
            const float qd = fexp2((float)(128 - itok) * l2b);
#pragma unroll
            for (int t = 0; t < 8; ++t) yacc[t] = yacc[t] + tacc[t] * qd;
        }
        float ss = 0.f;
#pragma unroll
        for (int t = 0; t < 8; ++t) ss += (yacc[t][0] * yacc[t][0] + yacc[t][1] * yacc[t][1]) + (yacc[t][2] * yacc[t][2] + yacc[t][3] * yacc[t][3]);
        ss += __shfl_xor(ss, 16); ss += __shfl_xor(ss, 32);
        const float rstd = 1.0f / sqrtf(ss * (1.0f / 128.0f) + EPS);
#pragma unroll
        for (int t = 0; t < 8; ++t) { const f32x4 gt = bf4(gtv[t]); f32x4 o;
#pragma unroll
            for (int i = 0; i < 4; ++i) o[i] = gt[i] * __builtin_amdgcn_rcpf(1.0f + fexp2(-gt[i] * LOG2E)) * yacc[t][i] * rstd;
            v2u w; w.x = pk2(o[0], o[1]); w.y = pk2(o[2], o[3]);
            *(v2u*)(CAT + tok * D + h * 128 + 16 * t + 4 * g) = w; }
        __syncthreads();
    }
}

__global__ void __launch_bounds__(512, 2) fwd_kernel(Params P) {
    extern __shared__ __attribute__((aligned(16))) unsigned char lds_raw[];
    LAS unsigned char* lds = (LAS unsigned char*)lds_raw;
    cg::grid_group grid = cg::this_grid();
    volatile LAS unsigned* bst = (volatile LAS unsigned*)(lds + LDS_BYTES - 64);
    if (threadIdx.x < 2) bst[threadIdx.x] = 0u;
    unsigned* barw = (unsigned*)P.ws;
    if (blockIdx.x == 0) for (int i = threadIdx.x; i < XCD_BAR_WORDS; i += 512) __hip_atomic_store(barw + i, 0u, __ATOMIC_RELAXED, __HIP_MEMORY_SCOPE_AGENT);
    prologue(P, lds);
    phase_rowpass0(P, 0);
    __threadfence();
    __syncthreads();
    grid.sync();
    const XcdBarrier xbar = xcd_barrier_post(barw, bst);
    for (int step = 0; step < 1 + 16 * NROUND; ++step) {
        int st = step; asm volatile("" : "+s"(st));
#if defined(__HIP_DEVICE_COMPILE__)
        const __attribute__((address_space(4))) Params* kp = (const __attribute__((address_space(4))) Params*)__builtin_amdgcn_kernarg_segment_ptr();
        asm volatile("" : "+s"(kp));
        Params Q;
        Q.x_prompt = kp->x_prompt; Q.x_sample = kp->x_sample; Q.mem_prompt = kp->mem_prompt; Q.mem_sample = kp->mem_sample; Q.norm_gain = kp->norm_gain; Q.mem_norm_gain = kp->mem_norm_gain;
        Q.w_mem_kv = kp->w_mem_kv; Q.w_out = kp->w_out; Q.w_mlp_in = kp->w_mlp_in; Q.w_mlp_out = kp->w_mlp_out; Q.w_in_ret = kp->w_in_ret; Q.ret_decay = kp->ret_decay;
        Q.w_in_na = kp->w_in_na; Q.na_rpb = kp->na_rpb; Q.out = kp->out; Q.ws = kp->ws;
#else
        Params Q = P;
#endif
        asm volatile("" : "+s"(Q.x_prompt), "+s"(Q.x_sample), "+s"(Q.mem_prompt), "+s"(Q.mem_sample), "+s"(Q.norm_gain), "+s"(Q.mem_norm_gain), "+s"(Q.w_mem_kv), "+s"(Q.w_out));
        asm volatile("" : "+s"(Q.w_mlp_in), "+s"(Q.w_mlp_out), "+s"(Q.w_in_ret), "+s"(Q.ret_decay), "+s"(Q.w_in_na), "+s"(Q.na_rpb), "+s"(Q.out), "+s"(Q.ws));
        unsigned char* ws = Q.ws;
        bf16* H = (bf16*)(ws + WS_X16); const float* RS = (const float*)(ws + WS_RSTD); bf16* QKV = (bf16*)(ws + WS_QKV); bf16* CAT = (bf16*)(ws + WS_CAT); bf16* MIX = (bf16*)(ws + WS_MIX); bf16* ST = (bf16*)(ws + WS_ST);
        const int si = st < 1 ? -1 : (st - 1) & 15, r = st < 1 ? 0 : (st - 1) >> 4;
        const int layer = si >= 9 ? 1 : 0;
        const float* gn = Q.norm_gain + (size_t)layer * 4 * D;
        if (st < 1 || si == 0 || si == 4 || si == 6 || si == 7 || si == 9 || si == 11 || si == 13 || si == 14) {
            const bool split = st < 1 && (gridDim.x & 1) == 0;
            const int nrep = (st < 1 && !split) ? 2 : 1;
            for (int rep = 0; rep < nrep; ++rep) {
                const bf16* A; const bf16* Bt; bf16* O; const float* rs = nullptr; int M = MC, N, K, act = 0, G = (int)gridDim.x, c = (int)blockIdx.x;
                if (st < 1) { const int ml = split ? (int)(blockIdx.x & 1) : rep; if (split) { G >>= 1; c >>= 1; }
                    A = (const bf16*)(ws + WS_MEMN) + (size_t)ml * MEMROWS * D; Bt = (const bf16*)(ws + WS_WMEM) + (size_t)ml * 1024 * D; O = (bf16*)(ws + WS_MEMKV) + (size_t)ml * MEMROWS * 1024; M = MEMROWS; N = 1024; K = D; }
                else if (si == 0) { A = H; rs = RS; Bt = (const bf16*)(ws + WS_WIN0); O = QKV; N = NIN0; K = D; }
                else if (si == 9) { A = H; rs = RS; Bt = (const bf16*)(ws + WS_WIN1); O = QKV; N = NIN1; K = D; }
                else if (si == 4 || si == 11) { A = CAT; Bt = (const bf16*)(ws + WS_WOUT) + (size_t)layer * D * D; O = MIX; N = D; K = D; }
                else if (si == 6 || si == 13) { A = H; rs = RS; Bt = (const bf16*)(ws + WS_WMI) + (size_t)layer * D * DFF; O = QKV; N = DFF; K = D; act = 1; }
                else { A = QKV; Bt = (const bf16*)(ws + WS_WMO) + (size_t)layer * D * DFF; O = MIX; N = D; K = DFF; }
                run_gemm(lds, A, Bt, M, N, K, O, N, act, G, c, rs);
            }
        } else if (si == 1 || si == 10) {
            mem_attn_phase(Q, lds, r, layer, QKV, layer ? NIN1 : NIN0, layer ? 4608 : 6144, CAT);
            if (si == 1) ret_kv_phase(Q, lds, r, QKV, ST); else na_phase(Q, lds, r, QKV, CAT);
        } else if (si == 2) ret_scan_phase(Q, r, ST);
        else if (si == 3) ret_out_phase(Q, lds, r, QKV, ST, CAT);
        else if (si == 5 || si == 8 || si == 12) phase_rowpass<false>(Q, r, (si == 8) ? gn + 3 * D : gn + D);
        else { phase_rowpass<true>(Q, r, gn + 3 * D); if (r + 1 < NROUND) phase_rowpass0(Q, r + 1); }
        if (st + 1 < 1 + 16 * NROUND) { XcdBarrier xb = xbar; asm volatile("" : "+s"(xb.bar), "+s"(xb.x));
            xcd_barrier(xb); }
    }
}

extern "C" void kernel_launch(void* const* d_in, const int* in_sizes, int n_in, void* d_out, int out_size, void* d_ws, size_t ws_size, hipStream_t stream) {
    static int grid = 0;
    if (grid == 0) {
        if (n_in != 14 || ws_size < WS_END) { fprintf(stderr, "kernel_launch: need 14 inputs and >= %zu bytes of workspace; got n_in %d, ws %zu\n", (size_t)WS_END, n_in, ws_size); grid = -1; return; }
        int dev = 0, cus = 0, per_cu = 0;
        (void)hipGetDevice(&dev); (void)hipDeviceGetAttribute(&cus, hipDeviceAttributeMultiprocessorCount, dev);
        if (hipFuncSetAttribute((const void*)fwd_kernel, hipFuncAttributeMaxDynamicSharedMemorySize, LDS_BYTES) != hipSuccess) { fprintf(stderr, "kernel_launch: hipFuncSetAttribute failed\n"); grid = -1; return; }
        if (hipOccupancyMaxActiveBlocksPerMultiprocessor(&per_cu, (const void*)fwd_kernel, 512, LDS_BYTES) != hipSuccess || per_cu < 1) { fprintf(stderr, "kernel_launch: occupancy query says %d blocks per CU\n", per_cu); per_cu = 1; }
        (void)hipGetLastError();
        grid = cus > 0 ? cus : 256;
    }
    if (grid < 0) return;
    Params p{};
    p.x_prompt = (const float*)d_in[0]; p.x_sample = (const float*)d_in[1]; p.mem_prompt = (const float*)d_in[2]; p.mem_sample = (const float*)d_in[3];
    p.norm_gain = (const float*)d_in[4]; p.mem_norm_gain = (const float*)d_in[5]; p.w_mem_kv = (const float*)d_in[6]; p.w_out = (const float*)d_in[7];
    p.w_mlp_in = (const float*)d_in[8]; p.w_mlp_out = (const float*)d_in[9]; p.w_in_ret = (const float*)d_in[10]; p.ret_decay = (const float*)d_in[11];
    p.w_in_na = (const float*)d_in[12]; p.na_rpb = (const float*)d_in[13];
    p.out = (float*)d_out; p.ws = (unsigned char*)d_ws;
    void* args[] = {&p};
    const hipError_t e = hipLaunchCooperativeKernel((const void*)fwd_kernel, dim3(grid), dim3(512), args, LDS_BYTES, stream);
    if (e != hipSuccess) fprintf(stderr, "kernel_launch: cooperative launch failed: %s (grid %d)\n", hipGetErrorString(e), grid);
}
```

```cpp
#include <hip/hip_runtime.h>
#include <hip/hip_cooperative_groups.h>
#include <cstdio>
#include <cstdint>
namespace cg = cooperative_groups;
namespace pg8 {
#define PG8_LAS __attribute__((address_space(3)))
typedef unsigned short bf16_t;
typedef short bf16x8 __attribute__((ext_vector_type(8)));
typedef float f32x4 __attribute__((ext_vector_type(4)));
typedef unsigned u32x4 __attribute__((ext_vector_type(4)));
constexpr int BM = 256, BK = 64, HALF = 128, HTB = HALF * BK * 2  , STAGE_BYTES = 8 * HTB, NXCD = 8, WGM = 4;

__host__ __device__ __forceinline__ int lds_byte(int r, int c) { const int st = (r >> 4) * 2 + (c >> 5), rr = r & 15, cc = c & 31, ob = rr * 64 + cc * 2; return st * 1024 + (ob ^ (((ob >> 9) & 1) << 5)); }
__host__ __device__ __forceinline__ void stage_rc(int b, int& R, int& C) { const int st = b / 1024, sb = b % 1024, swz = sb ^ (((sb >> 9) & 1) << 5); R = (st >> 1) * 16 + swz / 64; C = (st & 1) * 32 + (swz % 64) / 2; }
__host__ __device__ __forceinline__ int perm32(int rho) { const int n = rho >> 4, i = rho & 15; return 8 * (i >> 2) + 4 * n + (i & 3); }

struct Unit { int pm, pn; };
struct Gemm { const bf16_t* A; const bf16_t* Bt; int M, N, K; };

struct StaticOrder {
    int nM, nN, nwg, G, c;
    __host__ __device__ void init(int M, int N, int G_, int c_) { nM = M / BM; nN = N / BM; nwg = nM * nN; G = G_; c = c_; }
    __host__ __device__ bool next(int i, Unit& u) const {
        const long L = (long)i * G + c; if (L >= nwg) return false;
        int wgid = (int)L; { const int q = nwg / NXCD, r = nwg % NXCD, xcd = wgid % NXCD, off = wgid / NXCD; wgid = (xcd < r ? xcd * (q + 1) : r * (q + 1) + (xcd - r) * q) + off; }
        const int nig = WGM * nN, gid = wgid / nig, fm = gid * WGM, gsz = (nM - fm) < WGM ? (nM - fm) : WGM;
        u.pm = fm + ((wgid % nig) % gsz); u.pn = (wgid % nig) / gsz; return true;
    }
    __device__ __forceinline__ void a_ready(const Unit&) const {}
    __device__ __forceinline__ void done(const Unit&) const {}
};

__device__ __forceinline__ unsigned cvt_pk_bf16(float lo, float hi) { unsigned r; asm volatile("v_cvt_pk_bf16_f32 %0, %1, %2" : "=v"(r) : "v"(lo), "v"(hi)); return r; }
struct EpiAct {
    static constexpr bool PERM = true, AFTER_DRAIN = false;
    bf16_t* O; int ldc; int act; const float* rs;
    __device__ __forceinline__ void operator()(const f32x4 (&acc)[2][2][4][2], const Unit& u, int wr, int wc, int fr, int fq) const {
        const int row0 = u.pm * BM + wr * 64 + fr; const int col0 = u.pn * BM + wc * 32 + 8 * fq;
#pragma unroll
        for (int ai = 0; ai < 2; ++ai)
#pragma unroll
            for (int m = 0; m < 4; ++m) { const int row = row0 + ai * HALF + m * 16; bf16_t* rowp = O + (size_t)row * ldc + col0;
                const float sc = rs ? rs[row] : 1.0f;
#pragma unroll
                for (int bj = 0; bj < 2; ++bj) { f32x4 v0 = acc[ai][bj][m][0] * sc, v1 = acc[ai][bj][m][1] * sc;
                    if (act) {
#pragma unroll
                        for (int j = 0; j < 4; ++j) { const float a = fmaxf(v0[j], 0.f), b = fmaxf(v1[j], 0.f); v0[j] = a * a; v1[j] = b * b; } }
                    u32x4 w; w.x = cvt_pk_bf16(v0[0], v0[1]); w.y = cvt_pk_bf16(v0[2], v0[3]); w.z = cvt_pk_bf16(v1[0], v1[1]); w.w = cvt_pk_bf16(v1[2], v1[3]);
                    *(u32x4*)(rowp + bj * HALF) = w; } }
    }
};
template <class Epi, class Sched, bool ALIGN_EPI = false, bool SP2 = false>
__device__ __forceinline__ void gemm_phase(PG8_LAS unsigned char* lds, const Gemm g, const Sched& S, const Epi& E) {
    int tid_l = threadIdx.x; asm volatile("" : "+v"(tid_l)); const int tid = tid_l, wid = __builtin_amdgcn_readfirstlane(tid >> 6), lane = tid & 63, wr = wid >> 2, wc = wid & 3, fr = lane & 15, fq = lane >> 4;
    const int K = g.K, nt = K / BK;
    unsigned voffA[2], voffB[2];
#pragma unroll
    for (int i = 0; i < 2; ++i) { int R, C; stage_rc(tid * 16 + i * 8192, R, C); const int Rb = Epi::PERM ? ((R & ~31) + perm32(R & 31)) : R;
        voffA[i] = (unsigned)(R * K + C) * 2u; voffB[i] = (unsigned)(Rb * K + C) * 2u; }
    const size_t kstep = (size_t)(BK * 2);
    const size_t hstep = (size_t)HALF * K * 2;
    const size_t tstep = 2 * hstep;
    const unsigned ldsw = (unsigned)wid * 1024u;
    const int aoff = lds_byte(wr * 64 + fr, fq * 8), boff = lds_byte(wc * 32 + fr, fq * 8);
#define PG8_SA(b, h) (((b) * 2 + (h)) * HTB)
#define PG8_SB(b, h) ((4 + (b) * 2 + (h)) * HTB)
#define PG8_STAGE(bufoff, gbase, voff) do { _Pragma("unroll") for (int _i = 0; _i < 2; ++_i) \
        __builtin_amdgcn_global_load_lds((const unsigned*)((const char*)(gbase) + (voff)[_i]), (PG8_LAS unsigned*)(lds + (bufoff) + ldsw + _i * 8192), 16, 0, 0); } while (0)
#define PG8_LDA(dst, b, h) do { _Pragma("unroll") for (int m = 0; m < 4; ++m) _Pragma("unroll") for (int k = 0; k < 2; ++k) dst[m][k] = *(const PG8_LAS bf16x8*)(lds + PG8_SA(b, h) + aoff + m * 2048 + k * 1024); } while (0)
#define PG8_LDB(dst, b, h) do { _Pragma("unroll") for (int n = 0; n < 2; ++n) _Pragma("unroll") for (int k = 0; k < 2; ++k) dst[n][k] = *(const PG8_LAS bf16x8*)(lds + PG8_SB(b, h) + boff + n * 2048 + k * 1024); } while (0)
#define PG8_MMA(ai, bj, At, Bt) do { __builtin_amdgcn_s_setprio(1); _Pragma("unroll") for (int m = 0; m < 4; ++m) _Pragma("unroll") for (int n = 0; n < 2; ++n) _Pragma("unroll") for (int k = 0; k < 2; ++k) \
        acc[ai][bj][m][n] = __builtin_amdgcn_mfma_f32_16x16x32_bf16(Bt[n][k], At[m][k], acc[ai][bj][m][n], 0, 0, 0); __builtin_amdgcn_s_setprio(0); } while (0)
#define PG8_WAIT_V(n) asm volatile("s_waitcnt vmcnt(" #n ")" ::: "memory")
#define PG8_WAIT_L(n) asm volatile("s_waitcnt lgkmcnt(" #n ")" ::: "memory")
#define PG8_BAR __builtin_amdgcn_s_barrier()
#define PG8_SCHED __builtin_amdgcn_sched_barrier(0)
    Unit cur, nxt; int ui = 0;
    if (!S.next(0, cur)) return;
    f32x4 acc[2][2][4][2];
#pragma unroll
    for (int a = 0; a < 2; ++a)
#pragma unroll
        for (int b = 0; b < 2; ++b)
#pragma unroll
            for (int m = 0; m < 4; ++m)
#pragma unroll
                for (int n = 0; n < 2; ++n) acc[a][b][m][n] = (f32x4){0.f, 0.f, 0.f, 0.f};
    bf16x8 At[4][2], B0[2][2], B1[2][2];
    const char* cA = (const char*)g.A + (size_t)cur.pm * tstep; const char* cB = (const char*)g.Bt + (size_t)cur.pn * tstep;
    S.a_ready(cur);
    if constexpr (SP2) {
        PG8_STAGE(PG8_SB(0, 0), cB, voffB); PG8_STAGE(PG8_SB(0, 1), cB + hstep, voffB); PG8_STAGE(PG8_SA(0, 0), cA, voffA); PG8_STAGE(PG8_SA(0, 1), cA + hstep, voffA);
        if (wr == 1) PG8_BAR;
        PG8_WAIT_V(2); PG8_BAR;
        PG8_STAGE(PG8_SB(1, 0), cB + kstep, voffB); PG8_STAGE(PG8_SA(1, 0), cA + kstep, voffA); PG8_STAGE(PG8_SB(1, 1), cB + hstep + kstep, voffB);
        PG8_WAIT_V(6); PG8_BAR;
    } else {
        PG8_STAGE(PG8_SB(0, 0), cB, voffB); PG8_STAGE(PG8_SA(0, 0), cA, voffA); PG8_STAGE(PG8_SB(0, 1), cB + hstep, voffB); PG8_STAGE(PG8_SA(0, 1), cA + hstep, voffA);
        if (wr == 1) PG8_BAR;
        PG8_WAIT_V(4); PG8_BAR;
        PG8_STAGE(PG8_SB(1, 0), cB + kstep, voffB); PG8_STAGE(PG8_SA(1, 0), cA + kstep, voffA); PG8_STAGE(PG8_SB(1, 1), cB + hstep + kstep, voffB);
        PG8_WAIT_V(6); PG8_BAR;
    }
    for (;;) {
        const bool has_next = S.next(ui + 1, nxt);
        const char* nA = has_next ? (const char*)g.A + (size_t)nxt.pm * tstep : cA; const char* nB = has_next ? (const char*)g.Bt + (size_t)nxt.pn * tstep : cB;
        for (int t = 0; t < nt; t += 2) {
            const bool last = (t == nt - 2);
            const char* a1 = cA + (size_t)(t + 1) * kstep;
            const char* a2 = last ? nA : cA + (size_t)(t + 2) * kstep; const char* b2 = last ? nB : cB + (size_t)(t + 2) * kstep;
            const char* a3 = a2 + kstep; const char* b3 = b2 + kstep;
            if (last && has_next) S.a_ready(nxt);
            if constexpr (SP2) {
            PG8_LDB(B0, 0, 0); PG8_LDB(B1, 0, 1); PG8_SCHED; PG8_LDA(At, 0, 0); PG8_STAGE(PG8_SA(1, 1), a1 + hstep, voffA);
            PG8_WAIT_V(8); PG8_WAIT_L(0); PG8_BAR; PG8_MMA(0, 0, At, B0); PG8_MMA(0, 1, At, B1); PG8_BAR; PG8_SCHED;
            PG8_LDA(At, 0, 1); PG8_STAGE(PG8_SB(0, 0), b2, voffB); PG8_STAGE(PG8_SB(0, 1), b2 + hstep, voffB); PG8_STAGE(PG8_SA(0, 0), a2, voffA);
            PG8_WAIT_V(8); PG8_WAIT_L(0); PG8_BAR; PG8_MMA(1, 0, At, B0); PG8_MMA(1, 1, At, B1); PG8_BAR; PG8_SCHED;
            PG8_LDB(B0, 1, 0); PG8_LDB(B1, 1, 1); PG8_SCHED; PG8_LDA(At, 1, 0); PG8_STAGE(PG8_SA(0, 1), a2 + hstep, voffA);
            PG8_WAIT_V(8); PG8_WAIT_L(0); PG8_BAR; PG8_MMA(0, 0, At, B0); PG8_MMA(0, 1, At, B1); PG8_BAR; PG8_SCHED;
            PG8_LDA(At, 1, 1); PG8_STAGE(PG8_SB(1, 0), b3, voffB); PG8_STAGE(PG8_SB(1, 1), b3 + hstep, voffB); PG8_STAGE(PG8_SA(1, 0), a3, voffA);
            PG8_WAIT_V(8); PG8_WAIT_L(0); PG8_BAR; PG8_MMA(1, 0, At, B0); PG8_MMA(1, 1, At, B1); PG8_BAR; PG8_SCHED;
            } else {
            PG8_LDB(B0, 0, 0); PG8_SCHED; PG8_LDA(At, 0, 0); PG8_STAGE(PG8_SA(1, 1), a1 + hstep, voffA);
            PG8_WAIT_L(8); PG8_BAR; PG8_WAIT_L(0); PG8_MMA(0, 0, At, B0); PG8_BAR; PG8_SCHED;
            PG8_LDB(B1, 0, 1); PG8_STAGE(PG8_SB(0, 0), b2, voffB);
            PG8_BAR; PG8_WAIT_L(0); PG8_MMA(0, 1, At, B1); PG8_BAR;
            PG8_LDA(At, 0, 1); PG8_STAGE(PG8_SA(0, 0), a2, voffA);
            PG8_BAR; PG8_WAIT_L(0); PG8_MMA(1, 0, At, B0); PG8_BAR; PG8_SCHED;
            PG8_STAGE(PG8_SB(0, 1), b2 + hstep, voffB);
            PG8_WAIT_V(6); PG8_BAR; PG8_MMA(1, 1, At, B1); PG8_BAR;
            PG8_LDB(B0, 1, 0); PG8_SCHED; PG8_LDA(At, 1, 0); PG8_STAGE(PG8_SA(0, 1), a2 + hstep, voffA);
            PG8_WAIT_L(8); PG8_BAR; PG8_WAIT_L(0); PG8_MMA(0, 0, At, B0); PG8_BAR; PG8_SCHED;
            PG8_LDB(B1, 1, 1); PG8_STAGE(PG8_SB(1, 0), b3, voffB);
            PG8_BAR; PG8_WAIT_L(0); PG8_MMA(0, 1, At, B1); PG8_BAR;
            PG8_LDA(At, 1, 1); PG8_STAGE(PG8_SA(1, 0), a3, voffA);
            PG8_BAR; PG8_WAIT_L(0); PG8_MMA(1, 0, At, B0); PG8_BAR; PG8_SCHED;
            PG8_STAGE(PG8_SB(1, 1), b3 + hstep, voffB);
            PG8_WAIT_V(6); PG8_BAR; PG8_MMA(1, 1, At, B1); PG8_BAR;
            }
        }
        if constexpr (ALIGN_EPI) { if (wr == 0) PG8_BAR; }
        if constexpr (!Epi::AFTER_DRAIN) { E(acc, cur, wr, wc, fr, fq); S.done(cur); }
        if (!has_next) break;
#pragma unroll
        for (int a = 0; a < 2; ++a)
#pragma unroll
            for (int b = 0; b < 2; ++b)
#pragma unroll
                for (int m = 0; m < 4; ++m)
#pragma unroll
                    for (int n = 0; n < 2; ++n) acc[a][b][m][n] = (f32x4){0.f, 0.f, 0.f, 0.f};
        cur = nxt; cA = nA; cB = nB; ++ui;
        if constexpr (ALIGN_EPI) { if (wr == 1) PG8_BAR; }
    }
    PG8_WAIT_V(0);
    if constexpr (!ALIGN_EPI) { if (wr == 0) PG8_BAR; }
    PG8_BAR;
    if constexpr (Epi::AFTER_DRAIN) { E.fused(acc, cur, wr, wc, fr, fq, lds, wid, lane); S.done(cur); }
#undef PG8_SA
#undef PG8_SB
#undef PG8_STAGE
#undef PG8_LDA
#undef PG8_LDB
#undef PG8_MMA
#undef PG8_WAIT_V
#undef PG8_WAIT_L
#undef PG8_BAR
#undef PG8_SCHED
}
}
#define LAS __attribute__((address_space(3)))
#define DI __device__ __forceinline__
typedef unsigned short bf16;
typedef short bf16x8 __attribute__((ext_vector_type(8)));
typedef short s16x4 __attribute__((ext_vector_type(4)));
typedef float f32x4 __attribute__((ext_vector_type(4)));
typedef unsigned v4u __attribute__((ext_vector_type(4)));
typedef unsigned v2u __attribute__((ext_vector_type(2)));

constexpr int D = 2048, MC = 16384, NROUND = 4;
constexpr int NIN0 = 6656, NIN1 = 5120, DFF = 8192, NTH = 12;
constexpr int MEMROWS = 5120;
constexpr float EPS = 1e-6f;
constexpr int LDS_BYTES = 147456;
constexpr int PITCH = 272;
constexpr int PPITCH = 528;
constexpr float QK_SCALE = 0.08838834764831845f;
constexpr float LOG2E = 1.4426950408889634f;

constexpr size_t MiB = 1u << 20;
constexpr size_t WS_RSTD = 65536;
constexpr size_t WS_WIN0 = 1 * MiB;
constexpr size_t WS_WIN1 = WS_WIN0 + (size_t)NIN0 * D * 2;
constexpr size_t WS_WOUT = WS_WIN1 + (size_t)NIN1 * D * 2;
constexpr size_t WS_WMI = WS_WOUT + 2 * (size_t)D * D * 2;
constexpr size_t WS_WMO = WS_WMI + 2 * (size_t)DFF * D * 2;
constexpr size_t WS_WMEM = WS_WMO + 2 * (size_t)DFF * D * 2;
constexpr size_t WS_MEMN = WS_WMEM + 2 * (size_t)1024 * D * 2;
constexpr size_t WS_MEMKV = WS_MEMN + 2 * (size_t)MEMROWS * D * 2;
constexpr size_t WS_ROPE = WS_MEMKV + 2 * (size_t)MEMROWS * 1024 * 2;
constexpr size_t WS_H = WS_ROPE + 2 * (size_t)8192 * 64 * 4;
constexpr size_t WS_QKV = WS_H + (size_t)MC * D * 2;
constexpr size_t WS_CAT = WS_QKV + (size_t)MC * DFF * 2;
constexpr size_t WS_MIX = WS_CAT + (size_t)MC * D * 2;
constexpr size_t WS_ST = WS_MIX + (size_t)MC * D * 2;
constexpr size_t WS_X16 = WS_ST + 2 * (size_t)128 * 12 * 16384 * 2;
constexpr size_t WS_END = WS_X16 + (size_t)MC * D * 2;

struct Params {
    const float *x_prompt, *x_sample, *mem_prompt, *mem_sample, *norm_gain, *mem_norm_gain, *w_mem_kv, *w_out, *w_mlp_in, *w_mlp_out, *w_in_ret, *ret_decay, *w_in_na, *na_rpb;
    float* out; unsigned char* ws;
};

DI float bf2f(unsigned short b) { return __builtin_bit_cast(float, (unsigned)b << 16); }
DI unsigned short f2bf_sw(float f) { unsigned u = __builtin_bit_cast(unsigned, f); return (unsigned short)((u + 0x7fffu + ((u >> 16) & 1u)) >> 16); }
DI unsigned pk2(float lo, float hi) { return pg8::cvt_pk_bf16(lo, hi); }
DI unsigned short f2bf(float f) { return (unsigned short)(pg8::cvt_pk_bf16(f, f) & 0xffffu); }
DI float fexp2(float x) { return __builtin_amdgcn_exp2f(x); }
DI float wave_sum(float v) {
#pragma unroll
    for (int o = 1; o < 64; o <<= 1) v += __shfl_xor(v, o);
    return v;
}
DI int lbid() { int b = (int)blockIdx.x; asm volatile("" : "+s"(b)); return b; }
DI int lgdim() { int g = (int)gridDim.x; asm volatile("" : "+s"(g)); return g; }
DI float grp16_sum(float v) { v += __shfl_xor(v, 1); v += __shfl_xor(v, 2); v += __shfl_xor(v, 4); v += __shfl_xor(v, 8); return v; }
DI float grp16_max(float v) { v = fmaxf(v, __shfl_xor(v, 1)); v = fmaxf(v, __shfl_xor(v, 2)); v = fmaxf(v, __shfl_xor(v, 4)); v = fmaxf(v, __shfl_xor(v, 8)); return v; }
DI f32x4 mfma16(bf16x8 a, bf16x8 b, f32x4 c) { return __builtin_amdgcn_mfma_f32_16x16x32_bf16(a, b, c, 0, 0, 0); }
DI bf16x8 frag_row(const LAS unsigned char* img, int pitch, int r0, int k0, int lane) {
    return *(const LAS bf16x8*)(img + (r0 + (lane & 15)) * pitch + (k0 + 8 * (lane >> 4)) * 2);
}
DI bf16x8 frag_tr(const LAS unsigned char* img, int pitch, int k0, int c0, int lane) {
    const int g = lane >> 4, q = (lane & 15) >> 2, p = lane & 3;
    const LAS unsigned char* a = img + (k0 + 8 * g + q) * pitch + (c0 + 4 * p) * 2;
    const s16x4 lo = __builtin_amdgcn_ds_read_tr16_b64_v4i16((LAS s16x4*)a);
    const s16x4 hi = __builtin_amdgcn_ds_read_tr16_b64_v4i16((LAS s16x4*)(a + 4 * pitch));
    return __builtin_shufflevector(lo, hi, 0, 1, 2, 3, 4, 5, 6, 7);
}
DI bf16x8 frag_tr2(const LAS unsigned char* img, int pitch, int rb0, int rb1, int c0, int lane) {
    const int g = lane >> 4, q = (lane & 15) >> 2, p = lane & 3;
    const s16x4 lo = __builtin_amdgcn_ds_read_tr16_b64_v4i16((LAS s16x4*)(img + (rb0 + 4 * g + q) * pitch + (c0 + 4 * p) * 2));
    const s16x4 hi = __builtin_amdgcn_ds_read_tr16_b64_v4i16((LAS s16x4*)(img + (rb1 + 4 * g + q) * pitch + (c0 + 4 * p) * 2));
    return __builtin_shufflevector(lo, hi, 0, 1, 2, 3, 4, 5, 6, 7);
}
DI const float* xin_row(const Params& P, int t) { return t < 32768 ? P.x_prompt + (size_t)t * D : P.x_sample + (size_t)(t - 32768) * D; }

#define XB_TMO      128
#define XB_XCNT(j)  (256  + 64 * (j))
#define XB_XSUB(j)  (1280 + 64 * (j))
#define XB_XGEN(j)  (2304 + 64 * (j))
#define XB_TOP      3328
#define XB_TOPGEN   3392
#define XCD_BAR_WORDS 3456
#define XB_SPIN_CAP (1u << 18)

__device__ __forceinline__ unsigned xb_ld(unsigned* p)              { return __hip_atomic_load(p, __ATOMIC_RELAXED, __HIP_MEMORY_SCOPE_AGENT); }
__device__ __forceinline__ unsigned xb_add(unsigned* p, unsigned v) { return __hip_atomic_fetch_add(p, v, __ATOMIC_RELAXED, __HIP_MEMORY_SCOPE_AGENT); }
__device__ __forceinline__ unsigned xb_xcc_id() { return (unsigned)__builtin_amdgcn_s_getreg((3 << 11) | 20) & 0xFu; }
#define XB_SPIN(cond, bar) do { unsigned _sp = 0; while (cond) { __builtin_amdgcn_s_sleep(1); \
    if ((++_sp & 255u) == 0u) { if (xb_ld(&(bar)[XB_TMO])) break; if (_sp > XB_SPIN_CAP) { atomicAdd(&(bar)[XB_TMO], 1u); break; } } } } while (0)

struct XcdBarrier {
    unsigned* bar; unsigned x;
    volatile LAS unsigned* st;
};

__device__ __forceinline__ XcdBarrier xcd_barrier_post(unsigned* bar, volatile LAS unsigned* st) {
    XcdBarrier b; b.bar = bar; b.x = xb_xcc_id(); b.st = st;
    if (threadIdx.x == 0) (void)xb_add(&bar[XB_XCNT(b.x)], 1u);
    return b;
}
__device__ __forceinline__ void xcd_barrier_complete(unsigned* bar, unsigned x, unsigned& nloc, unsigned& nx) {
    const unsigned G = gridDim.x * gridDim.y * gridDim.z;
    unsigned sum, cnt, mine, sp = 0u;
    for (;;) {
        sum = 0u; cnt = 0u; mine = 0u;
#pragma unroll
        for (unsigned j = 0; j < 16; ++j) { const unsigned c = xb_ld(&bar[XB_XCNT(j)]); sum += c; cnt += (c > 0u) ? 1u : 0u; mine = (j == x) ? c : mine; }
        if (sum == G) break;
        __builtin_amdgcn_s_sleep(1);
        if ((++sp & 255u) == 0u) { if (xb_ld(&bar[XB_TMO])) break; if (sp > XB_SPIN_CAP) { atomicAdd(&bar[XB_TMO], 1u); break; } }
    }
    nloc = mine > 0u ? mine : 1u; nx = cnt > 0u ? cnt : 1u;
}

__device__ __forceinline__ void xcd_barrier(const XcdBarrier& b) {
    asm volatile("s_waitcnt vmcnt(0)" ::: "memory");
    __syncthreads();
    if (threadIdx.x == 0) {
        unsigned* bar = b.bar;
        __builtin_amdgcn_s_waitcnt(0);
        unsigned nloc = b.st[0], nx = b.st[1];
        if (nloc == 0u) { xcd_barrier_complete(bar, b.x, nloc, nx); b.st[0] = nloc; b.st[1] = nx; }
        const unsigned old = xb_add(&bar[XB_XSUB(b.x)], 1u);
        const unsigned gen = old / nloc;
        if (old + 1u == (gen + 1u) * nloc) {
            __builtin_amdgcn_fence(__ATOMIC_RELEASE, "agent");
            asm volatile("s_waitcnt vmcnt(0)" ::: "memory");
            const unsigned og = xb_add(&bar[XB_TOP], 1u);
            const unsigned tg = og / nx;
            if (og + 1u == (tg + 1u) * nx) xb_add(&bar[XB_TOPGEN], 1u);
            else XB_SPIN(xb_ld(&bar[XB_TOPGEN]) == tg, bar);
            __builtin_amdgcn_fence(__ATOMIC_ACQUIRE, "agent");
            xb_add(&bar[XB_XGEN(b.x)], 1u);
            asm volatile("s_waitcnt vmcnt(0)" ::: "memory");
        } else {
            XB_SPIN(xb_ld(&bar[XB_XGEN(b.x)]) == gen, bar);
            __builtin_amdgcn_fence(__ATOMIC_ACQUIRE, "agent");
            asm volatile("s_waitcnt vmcnt(0)" ::: "memory");
        }
    }
    __syncthreads();
}

DI f32x4 bf4(v2u raw) { return (f32x4){bf2f((unsigned short)(raw.x & 0xffffu)), bf2f((unsigned short)(raw.x >> 16)), bf2f((unsigned short)(raw.y & 0xffffu)), bf2f((unsigned short)(raw.y >> 16))}; }
template <bool HAS_MIX, bool WRITE_H, int NR, bool SRC16, bool DST16>
DI void row_pass(const void* xsrc, const bf16* mix, void* xdst, float* rsd, size_t rstride, int rsstride, const float* gpost, int lane) {
    f32x4 v[NR][8]; v2u mr[NR][8];
#pragma unroll
    for (int rr = 0; rr < NR; ++rr) {
        if (SRC16) {
#pragma unroll
            for (int j = 0; j < 8; ++j) { const v2u raw = ((const v2u*)((const bf16*)xsrc + rr * rstride))[lane + 64 * j]; v[rr][j] = bf4(raw); }
        } else {
#pragma unroll
            for (int j = 0; j < 8; ++j) v[rr][j] = __builtin_nontemporal_load((const f32x4*)((const float*)xsrc + rr * rstride) + lane + 64 * j);
        }
        if (HAS_MIX) {
#pragma unroll
            for (int j = 0; j < 8; ++j) mr[rr][j] = __builtin_nontemporal_load((const v2u*)(mix + rr * rstride) + lane + 64 * j); }
    }
    if (!HAS_MIX && DST16) {
#pragma unroll
        for (int rr = 0; rr < NR; ++rr)
#pragma unroll
            for (int j = 0; j < 8; ++j) { v2u w; w.x = pk2(v[rr][j].x, v[rr][j].y); w.y = pk2(v[rr][j].z, v[rr][j].w); ((v2u*)((bf16*)xdst + rr * rstride))[lane + 64 * j] = w; }
    }
    if (HAS_MIX) {
        float rstd[NR];
#pragma unroll
        for (int rr = 0; rr < NR; ++rr) { float ss = 0.f;
#pragma unroll
            for (int j = 0; j < 8; ++j) { const f32x4 m = bf4(mr[rr][j]); ss += (m.x * m.x + m.y * m.y) + (m.z * m.z + m.w * m.w); }
            rstd[rr] = 1.0f / sqrtf(wave_sum(ss) * (1.0f / D) + EPS); }
#pragma unroll
        for (int j = 0; j < 8; ++j) { const f32x4 g = ((const f32x4*)gpost)[lane + 64 * j];
#pragma unroll
            for (int rr = 0; rr < NR; ++rr) { v[rr][j] = v[rr][j] + bf4(mr[rr][j]) * rstd[rr] * g;
                if (DST16) { v2u w; w.x = pk2(v[rr][j].x, v[rr][j].y); w.y = pk2(v[rr][j].z, v[rr][j].w); ((v2u*)((bf16*)xdst + rr * rstride))[lane + 64 * j] = w; }
                else __builtin_nontemporal_store(v[rr][j], (f32x4*)((float*)xdst + rr * rstride) + lane + 64 * j); } }
    }
    if (WRITE_H) {
#pragma unroll
        for (int rr = 0; rr < NR; ++rr) { float ss = 0.f;
#pragma unroll
            for (int j = 0; j < 8; ++j) ss += (v[rr][j].x * v[rr][j].x + v[rr][j].y * v[rr][j].y) + (v[rr][j].z * v[rr][j].z + v[rr][j].w * v[rr][j].w);
            const float rstd = 1.0f / sqrtf(wave_sum(ss) * (1.0f / D) + EPS);
            if (lane == 0) rsd[rr * rsstride] = rstd; }
    }
}

DI void transpose_item(const float* W, int K, int N, bf16* WT, LAS float* scr, int item, int lane, const float* gk) {
    const int nblk = N / 32, kb = item / nblk, nb = item % nblk, k0 = 64 * kb, n0 = 32 * nb;
#pragma unroll
    for (int i = 0; i < 32; ++i) { const int kk = 2 * i + (lane >> 5); const float gv = gk ? gk[k0 + kk] : 1.0f; scr[kk * 33 + (lane & 31)] = __builtin_nontemporal_load(W + (size_t)(k0 + kk) * N + n0 + (lane & 31)) * gv; }
    __builtin_amdgcn_fence(__ATOMIC_RELEASE, "workgroup"); asm volatile("s_waitcnt lgkmcnt(0)" ::: "memory");
    const int c = lane & 7;
#pragma unroll
    for (int j = 0; j < 4; ++j) { const int n = (lane >> 3) + 8 * j; const LAS float* s = scr + (8 * c) * 33 + n;
        v4u o; o.x = pk2(s[0 * 33], s[1 * 33]); o.y = pk2(s[2 * 33], s[3 * 33]); o.z = pk2(s[4 * 33], s[5 * 33]); o.w = pk2(s[6 * 33], s[7 * 33]);
        *(v4u*)(WT + (size_t)(n0 + n) * K + k0 + 8 * c) = o; }
    asm volatile("s_waitcnt lgkmcnt(0)" ::: "memory");
}

DI void prologue(const Params& P, LAS unsigned char* lds) {
    int tid_l = threadIdx.x; asm volatile("" : "+v"(tid_l)); const int tid = tid_l, lane = tid & 63, wave = __builtin_amdgcn_readfirstlane(tid >> 6);
    LAS float* scr = (LAS float*)(lds + wave * 16384);
    const int gw = lbid() * 8 + wave, NGW = lgdim() * 8;
    unsigned char* ws = P.ws;
    constexpr int I0 = 32 * (NIN0 / 32), I1 = 32 * (NIN1 / 32), IO = 32 * 64, IMI = 32 * 256, IMO = 128 * 64, IME = 32 * 32;
    constexpr int NITEMS = I0 + I1 + 2 * IO + 2 * IMI + 2 * IMO + 2 * IME;
    for (int it = gw; it < NITEMS; it += NGW) {
        int q = it;
        if (q < I0) { transpose_item(P.w_in_ret, D, NIN0, (bf16*)(ws + WS_WIN0), scr, q, lane, P.norm_gain); continue; } q -= I0;
        if (q < I1) { transpose_item(P.w_in_na, D, NIN1, (bf16*)(ws + WS_WIN1), scr, q, lane, P.norm_gain + 4 * D); continue; } q -= I1;
        if (q < 2 * IO) { const int i = q / IO; transpose_item(P.w_out + (size_t)i * D * D, D, D, (bf16*)(ws + WS_WOUT) + (size_t)i * D * D, scr, q % IO, lane, nullptr); continue; } q -= 2 * IO;
        if (q < 2 * IMI) { const int i = q / IMI; transpose_item(P.w_mlp_in + (size_t)i * D * DFF, D, DFF, (bf16*)(ws + WS_WMI) + (size_t)i * D * DFF, scr, q % IMI, lane, P.norm_gain + (size_t)i * 4 * D + 2 * D); continue; } q -= 2 * IMI;
        if (q < 2 * IMO) { const int i = q / IMO; transpose_item(P.w_mlp_out + (size_t)i * D * DFF, DFF, D, (bf16*)(ws + WS_WMO) + (size_t)i * D * DFF, scr, q % IMO, lane, nullptr); continue; } q -= 2 * IMO;
        { const int i = q / IME; transpose_item(P.w_mem_kv + (size_t)i * D * 1024, D, 1024, (bf16*)(ws + WS_WMEM) + (size_t)i * D * 1024, scr, q % IME, lane, nullptr); }
    }
    float* rc = (float*)(ws + WS_ROPE); float* rs = rc + 8192 * 64;
    for (int idx = lbid() * 512 + tid; idx < 8192 * 64; idx += lgdim() * 512) {
        const int pos = idx >> 6, i = idx & 63;
        const float inv = powf(10000.0f, -(float)i / 64.0f);
        const float ang = (float)pos * inv;
        rc[idx] = cosf(ang); rs[idx] = sinf(ang);
    }
    bf16* memn = (bf16*)(ws + WS_MEMN);
    for (int row = gw; row < MEMROWS; row += NGW) {
        const float* src = row < 4096 ? P.mem_prompt + (size_t)row * D : P.mem_sample + (size_t)(row - 4096) * D;
        f32x4 v[8]; float ss = 0.f;
#pragma unroll
        for (int j = 0; j < 8; ++j) { v[j] = ((const f32x4*)src)[lane + 64 * j]; ss += (v[j].x * v[j].x + v[j].y * v[j].y) + (v[j].z * v[j].z + v[j].w * v[j].w); }
        const float rstd = 1.0f / sqrtf(wave_sum(ss) * (1.0f / D) + EPS);
#pragma unroll
        for (int i = 0; i < 2; ++i)
#pragma unroll
            for (int j = 0; j < 8; ++j) { const f32x4 g = ((const f32x4*)(P.mem_norm_gain + i * D))[lane + 64 * j]; const f32x4 o = v[j] * rstd * g;
                v2u w; w.x = pk2(o.x, o.y); w.y = pk2(o.z, o.w); ((v2u*)(memn + ((size_t)i * MEMROWS + row) * D))[lane + 64 * j] = w; }
    }
}

DI void phase_rowpass0(const Params& P, int r) {
    int tid_l = threadIdx.x; asm volatile("" : "+v"(tid_l)); const int lane = tid_l & 63, wave = tid_l >> 6;
    bf16* X16 = (bf16*)(P.ws + WS_X16); float* RS = (float*)(P.ws + WS_RSTD); const float* xb = xin_row(P, r * MC);
    const int NGW = lgdim() * 8;
    for (int row = lbid() * 8 + wave; row < MC; row += 2 * NGW) {
        const size_t o = (size_t)row * D;
        if (row + NGW < MC) row_pass<false, true, 2, false, true>(xb + o, nullptr, X16 + o, RS + row, (size_t)NGW * D, NGW, nullptr, lane);
        else row_pass<false, true, 1, false, true>(xb + o, nullptr, X16 + o, RS + row, 0, 0, nullptr, lane);
    }
}
template <bool FINAL>
DI void phase_rowpass(const Params& P, int r, const float* gpost) {
    int tid_l = threadIdx.x; asm volatile("" : "+v"(tid_l)); const int lane = tid_l & 63, wave = tid_l >> 6;
    const bf16* MIX = (const bf16*)(P.ws + WS_MIX); bf16* X16 = (bf16*)(P.ws + WS_X16); float* RS = (float*)(P.ws + WS_RSTD);
    float* xo = P.out + (size_t)r * MC * D;
    const int NGW = lgdim() * 8;
    for (int row = lbid() * 8 + wave; row < MC; row += 2 * NGW) {
        const size_t o = (size_t)row * D;
        void* dst = FINAL ? (void*)(xo + o) : (void*)(X16 + o);
        if (row + NGW < MC) row_pass<true, !FINAL, 2, true, !FINAL>(X16 + o, MIX + o, dst, RS + row, (size_t)NGW * D, NGW, gpost, lane);
        else row_pass<true, !FINAL, 1, true, !FINAL>(X16 + o, MIX + o, dst, RS + row, 0, 0, gpost, lane);
    }
}

DI void run_gemm(LAS unsigned char* lds, const bf16* A, const bf16* Bt, int M, int N, int K, bf16* O, int ldc, int act, int G, int c, const float* rs) {
    pg8::Gemm g{A, Bt, M, N, K}; pg8::StaticOrder S; S.init(M, N, G, c);
    pg8::EpiAct E{O, ldc, act, rs};
    pg8::gemm_phase<pg8::EpiAct, pg8::StaticOrder, true, true>(lds, g, S, E);
}

DI void mem_attn_phase(const Params& P, LAS unsigned char* lds, int r, int layer, const bf16* QKV, int nin, int qoff, bf16* CAT) {
    int tid_l = threadIdx.x; asm volatile("" : "+v"(tid_l)); const int tid = tid_l, lane = tid & 63, wave = __builtin_amdgcn_readfirstlane(tid >> 6), g0 = lane >> 4, li0 = lane & 15;
    const bf16* MEMKV = (const bf16*)(P.ws + WS_MEMKV) + (size_t)layer * MEMROWS * 1024;
    const int L = r < 2 ? 2048 : 8192; const int memrow0 = r < 2 ? r * 8 * 256 : 4096 + (r - 2) * 2 * 256;
    LAS unsigned char* KI = lds; LAS unsigned char* VI = lds + 69632;
    for (int u = lbid(); u < 512; u += lgdim()) {
        int g = g0, li = li0; asm volatile("" : "+v"(g), "+v"(li));
        const int h = u & 3, qt = u >> 2;
        const int s = (qt * 128) / L;
        const bf16* kb = MEMKV + (size_t)(memrow0 + s * 256) * 1024 + h * 128;
        { v4u kreg[8], vreg[8];
        _Pragma("unroll") for (int it_ = 0; it_ < 8; ++it_) { const int task = tid + 512 * it_; const int m = task >> 4, c = task & 15;
            kreg[it_] = *(const v4u*)(kb + (size_t)m * 1024 + c * 8); vreg[it_] = *(const v4u*)(kb + (size_t)m * 1024 + 512 + c * 8); }
        asm volatile("" ::: "memory");
        _Pragma("unroll") for (int it_ = 0; it_ < 8; ++it_) { const int task = tid + 512 * it_; const int m = task >> 4, c = task & 15;
            *(LAS v4u*)(KI + m * PITCH + c * 16) = kreg[it_]; *(LAS v4u*)(VI + m * PITCH + c * 16) = vreg[it_]; } }
        __syncthreads();
        const int row0 = qt * 128 + wave * 16;
        const bf16* qp = QKV + (size_t)(row0 + li) * nin + qoff + h * 128 + 8 * g;
        bf16x8 qa[4];
#pragma unroll
        for (int ks = 0; ks < 4; ++ks) qa[ks] = __builtin_nontemporal_load((const bf16x8*)(qp + 32 * ks));
        f32x4 sacc[16];
#pragma unroll
        for (int t = 0; t < 16; ++t) sacc[t] = (f32x4){0.f, 0.f, 0.f, 0.f};
#pragma unroll
        for (int tb = 0; tb < 4; ++tb)
#pragma unroll
            for (int ks = 0; ks < 4; ++ks) { bf16x8 kf[4];
#pragma unroll
                for (int t = 0; t < 4; ++t) kf[t] = frag_row(KI, PITCH, 16 * (4 * tb + t), 32 * ks, lane);
                __builtin_amdgcn_sched_barrier(0);
#pragma unroll
                for (int t = 0; t < 4; ++t) sacc[4 * tb + t] = mfma16(qa[ks], kf[t], sacc[4 * tb + t]);
                __builtin_amdgcn_sched_barrier(0); }
        float inv[4];
#pragma unroll
        for (int i = 0; i < 4; ++i) { float mx = -INFINITY;
#pragma unroll
            for (int t = 0; t < 16; ++t) mx = fmaxf(mx, sacc[t][i]);
            mx = grp16_max(mx); float sm = 0.f;
#pragma unroll
            for (int t = 0; t < 16; ++t) { const float e = fexp2((sacc[t][i] - mx) * (QK_SCALE * LOG2E)); sacc[t][i] = e; sm += e; }
            inv[i] = 1.0f / grp16_sum(sm); }
        __syncthreads();
#pragma unroll
        for (int t = 0; t < 16; ++t)
#pragma unroll
            for (int i = 0; i < 4; ++i) ((LAS unsigned short*)(KI + (wave * 16 + 4 * g + i) * PPITCH))[16 * t + li] = f2bf(sacc[t][i] * inv[i]);
        __syncthreads();
        f32x4 oacc[8];
#pragma unroll
        for (int t = 0; t < 8; ++t) oacc[t] = (f32x4){0.f, 0.f, 0.f, 0.f};
#pragma unroll
        for (int ks = 0; ks < 8; ++ks) { const bf16x8 pa = frag_row(KI, PPITCH, wave * 16, 32 * ks, lane);
#pragma unroll
            for (int th = 0; th < 2; ++th) { bf16x8 vf[4];
#pragma unroll
                for (int t = 0; t < 4; ++t) vf[t] = frag_tr(VI, PITCH, 32 * ks, 16 * (4 * th + t), lane);
                __builtin_amdgcn_sched_barrier(0);
#pragma unroll
                for (int t = 0; t < 4; ++t) oacc[4 * th + t] = mfma16(pa, vf[t], oacc[4 * th + t]);
                __builtin_amdgcn_sched_barrier(0); } }
#pragma unroll
        for (int t = 0; t < 8; ++t)
#pragma unroll
            for (int i = 0; i < 4; ++i) CAT[(size_t)(row0 + 4 * g + i) * D + 1536 + h * 128 + 16 * t + li] = f2bf(oacc[t][i]);
        __syncthreads();
    }
}

DI void na_phase(const Params& P, LAS unsigned char* lds, int r, const bf16* QKV, bf16* CAT) {
    int tid_l = threadIdx.x; asm volatile("" : "+v"(tid_l)); const int tid = tid_l, lane = tid & 63, wave = __builtin_amdgcn_readfirstlane(tid >> 6), g0 = lane >> 4, li0 = lane & 15;
    const int L = r < 2 ? 2048 : 8192, rows = L / 64;
    constexpr int KVROW = 64 * PITCH;
    LAS unsigned char* PB = lds + 4 * KVROW + wave * 2560;
    LAS float* RB = (LAS float*)(lds + 4 * KVROW + 8 * 2560);
    const int qr = wave >> 1, cbp = (wave & 1) * 2;
    for (int u = lbid(); u < 64 * NTH; u += lgdim()) {
        int g = g0, li = li0; asm volatile("" : "+v"(g), "+v"(li));
        const int h = u % NTH, band = u / NTH;
        const int gr0 = band * 4, s = (gr0 * 64) / L, rin0 = gr0 - s * rows;
        const int rin = rin0 + qr, rs = min(max(rin - 4, 0), rows - 8);
        const int ks0 = min(max(rin0 - 4, 0), rows - 8), nsteps = min(max(rin0 - 1, 0), rows - 8) + 8 - ks0;
        for (int idx = tid; idx < 465; idx += 512) RB[idx] = P.na_rpb[h * 465 + idx];
        bf16x8 qa[2][4];
#pragma unroll
        for (int tl = 0; tl < 2; ++tl) { const bf16* qp = QKV + (size_t)((gr0 + qr) * 64 + (cbp + tl) * 16 + li) * NIN1 + h * 128 + 8 * g;
#pragma unroll
            for (int ks = 0; ks < 4; ++ks) qa[tl][ks] = __builtin_nontemporal_load((const bf16x8*)(qp + 32 * ks)); }
        f32x4 oacc[2][8]; float mrun[2], lrun[2];
#pragma unroll
        for (int tl = 0; tl < 2; ++tl) {
#pragma unroll
            for (int t = 0; t < 8; ++t) oacc[tl][t] = (f32x4){0.f, 0.f, 0.f, 0.f};
            mrun[tl] = -INFINITY; lrun[tl] = 0.f; }
        int dco[2][2][4];
#pragma unroll
        for (int tl = 0; tl < 2; ++tl) { const int cb = cbp + tl, c = cb * 16 + li, wst = min(max(c - 8, 0), 48), blk = min(max(16 * cb - 8, 0), 32);
#pragma unroll
            for (int hf = 0; hf < 2; ++hf)
#pragma unroll
                for (int i = 0; i < 4; ++i) { const int kcol = blk + 16 * hf + 4 * g + i; const bool valid = (kcol >= wst) && (kcol < wst + 16);
                    dco[tl][hf][i] = valid ? min(max(kcol - c + 15, 0), 30) : -1; } }
        const bf16* kvb = QKV + (size_t)((s * rows + ks0) * 64) * NIN1 + 1536 + h * 128;
        const int key0 = tid >> 4, ch = tid & 15;
        const size_t po0 = (size_t)key0 * NIN1 + ch * 8, po1 = po0 + (size_t)32 * NIN1;
        const int lo0 = key0 * PITCH + ch * 16, lo1 = lo0 + 32 * PITCH;
        v4u kr0, kr1, vr0, vr1;
        kr0 = *(const v4u*)(kvb + po0); kr1 = *(const v4u*)(kvb + po1); vr0 = *(const v4u*)(kvb + 1536 + po0); vr1 = *(const v4u*)(kvb + 1536 + po1);
        *(LAS v4u*)(lds + lo0) = kr0; *(LAS v4u*)(lds + lo1) = kr1; *(LAS v4u*)(lds + KVROW + lo0) = vr0; *(LAS v4u*)(lds + KVROW + lo1) = vr1;
        if (nsteps > 1) { const bf16* nb = kvb + (size_t)64 * NIN1;
            kr0 = *(const v4u*)(nb + po0); kr1 = *(const v4u*)(nb + po1); vr0 = *(const v4u*)(nb + 1536 + po0); vr1 = *(const v4u*)(nb + 1536 + po1); }
        __syncthreads();
        for (int k = 0; k < nsteps; ++k) {
            const int kr = ks0 + k;
            const LAS unsigned char* KI = lds + (k & 1) * 2 * KVROW; const LAS unsigned char* VI = KI + KVROW;
            if (kr >= rs && kr < rs + 8) {
                const int dr = kr - rin + 7;
#pragma unroll
                for (int tl = 0; tl < 2; ++tl) {
                    const int cb = cbp + tl, c0 = cb * 16, blk = min(max(16 * cb - 8, 0), 32);
                    f32x4 sc[2];
#pragma unroll
                    for (int hf = 0; hf < 2; ++hf) { sc[hf] = (f32x4){0.f, 0.f, 0.f, 0.f};
#pragma unroll
                        for (int ks = 0; ks < 4; ++ks) sc[hf] = mfma16(frag_row(KI, PITCH, blk + 16 * hf, 32 * ks, lane), qa[tl][ks], sc[hf]); }
                    float mx = -INFINITY; float bvs[2][4];
#pragma unroll
                    for (int hf = 0; hf < 2; ++hf)
#pragma unroll
                        for (int i = 0; i < 4; ++i) bvs[hf][i] = RB[dr * 31 + max(dco[tl][hf][i], 0)];
                    asm volatile("" : "+v"(bvs[0][0]), "+v"(bvs[0][1]), "+v"(bvs[0][2]), "+v"(bvs[0][3]), "+v"(bvs[1][0]), "+v"(bvs[1][1]), "+v"(bvs[1][2]), "+v"(bvs[1][3]));
#pragma unroll
                    for (int hf = 0; hf < 2; ++hf)
#pragma unroll
                        for (int i = 0; i < 4; ++i) { const float sv = dco[tl][hf][i] >= 0 ? sc[hf][i] * QK_SCALE + bvs[hf][i] : -INFINITY; sc[hf][i] = sv; mx = fmaxf(mx, sv); }
                    if (kr == rs) { mx = fmaxf(mx, __shfl_xor(mx, 16)); mx = fmaxf(mx, __shfl_xor(mx, 32)); mrun[tl] = mx; }
                    float ps = 0.f;
#pragma unroll
                    for (int hf = 0; hf < 2; ++hf)
#pragma unroll
                        for (int i = 0; i < 4; ++i) { const float p = fexp2(fminf((sc[hf][i] - mrun[tl]) * LOG2E, 100.0f)); sc[hf][i] = p; ps += p; }
                    lrun[tl] += ps;
                    v4u pw; pw.x = pk2(sc[0][0], sc[0][1]); pw.y = pk2(sc[0][2], sc[0][3]); pw.z = pk2(sc[1][0], sc[1][1]); pw.w = pk2(sc[1][2], sc[1][3]);
                    const bf16x8 pf = __builtin_bit_cast(bf16x8, pw);
#pragma unroll
                    for (int t = 0; t < 8; ++t) { oacc[tl][t] = mfma16(frag_tr2(VI, PITCH, blk, blk + 16, 16 * t, lane), pf, oacc[tl][t]); if ((t & 3) == 3) __builtin_amdgcn_sched_barrier(0); }
                }
            }
            if (k + 1 < nsteps) { LAS unsigned char* nk = lds + ((k + 1) & 1) * 2 * KVROW;
                *(LAS v4u*)(nk + lo0) = kr0; *(LAS v4u*)(nk + lo1) = kr1; *(LAS v4u*)(nk + KVROW + lo0) = vr0; *(LAS v4u*)(nk + KVROW + lo1) = vr1;
                if (k + 2 < nsteps) { const bf16* nb = kvb + (size_t)(k + 2) * 64 * NIN1;
                    kr0 = *(const v4u*)(nb + po0); kr1 = *(const v4u*)(nb + po1); vr0 = *(const v4u*)(nb + 1536 + po0); vr1 = *(const v4u*)(nb + 1536 + po1); } }
            __syncthreads();
        }
#pragma unroll
        for (int tl = 0; tl < 2; ++tl) { float lt = lrun[tl]; lt += __shfl_xor(lt, 16); lt += __shfl_xor(lt, 32); const float inv = 1.0f / lt;
            bf16* op = CAT + (size_t)((gr0 + qr) * 64 + (cbp + tl) * 16 + li) * D + h * 128 + 4 * g;
#pragma unroll
            for (int t = 0; t < 8; ++t) { v2u w; w.x = pk2(oacc[tl][t][0] * inv, oacc[tl][t][1] * inv); w.y = pk2(oacc[tl][t][2] * inv, oacc[tl][t][3] * inv); *(v2u*)(op + 16 * t) = w; } }
    }
}

DI float ret_log2gamma(const Params& P, int dir, int h) { const float de = P.ret_decay[dir * NTH + h]; return log1pf(-exp2f(-de)) * LOG2E; }

DI void ret_kv_phase(const Params& P, LAS unsigned char* lds, int r, const bf16* QKV, bf16* ST) {
    int tid_l = threadIdx.x; asm volatile("" : "+v"(tid_l)); const int tid = tid_l, lane = tid & 63, wave = __builtin_amdgcn_readfirstlane(tid >> 6), g0 = lane >> 4, li0 = lane & 15;
    const int L = r < 2 ? 2048 : 8192, cps = L / 128;
    LAS unsigned char* KF = lds; LAS unsigned char* KB = lds + 34816; LAS unsigned char* VI = lds + 69632;
    const float* rc = (const float*)(P.ws + WS_ROPE); const float* rsn = rc + 8192 * 64;
    for (int u = lbid(); u < 128 * NTH; u += lgdim()) {
        int g = g0, li = li0; asm volatile("" : "+v"(g), "+v"(li));
        const int n = u / NTH, h = u % NTH;
        const int tokbase = n * 128, pos0 = (n % cps) * 128;
        const float l2f = ret_log2gamma(P, 0, h), l2b = ret_log2gamma(P, 1, h);
        _Pragma("unroll") for (int it_ = 0; it_ < 2; ++it_) { const int task = tid + 512 * it_; const int j = task >> 3, dg = task & 7;
            const bf16* kp = QKV + (size_t)(tokbase + j) * NIN0 + 1536 + h * 128 + dg * 8;
            const bf16x8 lo = *(const bf16x8*)kp, hi = *(const bf16x8*)(kp + 64);
            const float* cp = rc + (size_t)(pos0 + j) * 64 + dg * 8; const float* sp = rsn + (size_t)(pos0 + j) * 64 + dg * 8;
            const f32x4 c0 = *(const f32x4*)cp, c1 = *(const f32x4*)(cp + 4), s0 = *(const f32x4*)sp, s1 = *(const f32x4*)(sp + 4);
            const float wf = QK_SCALE * fexp2((float)(127 - j) * l2f), wb = QK_SCALE * fexp2((float)j * l2b);
            float o1[8], o2[8];
#pragma unroll
            for (int e = 0; e < 8; ++e) { const float x1 = bf2f((unsigned short)lo[e]), x2 = bf2f((unsigned short)hi[e]); const float c = e < 4 ? c0[e & 3] : c1[e & 3], s = e < 4 ? s0[e & 3] : s1[e & 3];
                o1[e] = x1 * c - x2 * s; o2[e] = x1 * s + x2 * c; }
            v4u a, b, c, d;
            a.x = pk2(o1[0] * wf, o1[1] * wf); a.y = pk2(o1[2] * wf, o1[3] * wf); a.z = pk2(o1[4] * wf, o1[5] * wf); a.w = pk2(o1[6] * wf, o1[7] * wf);
            b.x = pk2(o2[0] * wf, o2[1] * wf); b.y = pk2(o2[2] * wf, o2[3] * wf); b.z = pk2(o2[4] * wf, o2[5] * wf); b.w = pk2(o2[6] * wf, o2[7] * wf);
            c.x = pk2(o1[0] * wb, o1[1] * wb); c.y = pk2(o1[2] * wb, o1[3] * wb); c.z = pk2(o1[4] * wb, o1[5] * wb); c.w = pk2(o1[6] * wb, o1[7] * wb);
            d.x = pk2(o2[0] * wb, o2[1] * wb); d.y = pk2(o2[2] * wb, o2[3] * wb); d.z = pk2(o2[4] * wb, o2[5] * wb); d.w = pk2(o2[6] * wb, o2[7] * wb);
            *(LAS v4u*)(KF + j * PITCH + dg * 16) = a; *(LAS v4u*)(KF + j * PITCH + 128 + dg * 16) = b;
            *(LAS v4u*)(KB + j * PITCH + dg * 16) = c; *(LAS v4u*)(KB + j * PITCH + 128 + dg * 16) = d; }
        _Pragma("unroll") for (int it_ = 0; it_ < 4; ++it_) { const int task = tid + 512 * it_; const int j = task >> 4, c = task & 15;
            *(LAS v4u*)(VI + j * PITCH + c * 16) = *(const v4u*)(QKV + (size_t)(tokbase + j) * NIN0 + 3072 + h * 128 + c * 8); }
        __syncthreads();
        f32x4 af[8], ab[8];
#pragma unroll
        for (int t = 0; t < 8; ++t) { af[t] = (f32x4){0.f, 0.f, 0.f, 0.f}; ab[t] = (f32x4){0.f, 0.f, 0.f, 0.f}; }
#pragma unroll
        for (int ks = 0; ks < 4; ++ks) { const bf16x8 kf = frag_tr(KF, PITCH, 32 * ks, 16 * wave, lane), kb = frag_tr(KB, PITCH, 32 * ks, 16 * wave, lane);
#pragma unroll
            for (int t = 0; t < 8; ++t) { if ((t & 3) == 0) __builtin_amdgcn_sched_barrier(0); const bf16x8 bv = frag_tr(VI, PITCH, 32 * ks, 16 * t, lane); af[t] = mfma16(bv, kf, af[t]); ab[t] = mfma16(bv, kb, ab[t]); }
            __builtin_amdgcn_sched_barrier(0); }
        bf16* sf = ST + ((size_t)(0 * 128 + n) * NTH + h) * 16384; bf16* sb = ST + ((size_t)(1 * 128 + n) * NTH + h) * 16384;
#pragma unroll
        for (int t = 0; t < 8; ++t)
        { const int o = (16 * wave + li) * 128 + 16 * t + 4 * g; v2u wf, wb; wf.x = pk2(af[t][0], af[t][1]); wf.y = pk2(af[t][2], af[t][3]); wb.x = pk2(ab[t][0], ab[t][1]); wb.y = pk2(ab[t][2], ab[t][3]);
            *(v2u*)(sf + o) = wf; *(v2u*)(sb + o) = wb; }
        __syncthreads();
    }
}

DI void ret_scan_phase(const Params& P, int r, bf16* ST) {
    const int L = r < 2 ? 2048 : 8192, cps = L / 128, nseq = MC / L;
    const int ntask = nseq * NTH * 2 * 2048;
    int tid_l = threadIdx.x; asm volatile("" : "+v"(tid_l));
    for (int task = lbid() * 512 + tid_l; task < ntask; task += lgdim() * 512) {
        const int eg = task & 2047; int rest = task >> 11; const int dir = rest & 1; rest >>= 1; const int h = rest % NTH, s = rest / NTH;
        const float decay = exp2f(128.0f * ret_log2gamma(P, dir, h));
        float st[8];
#pragma unroll
        for (int e = 0; e < 8; ++e) st[e] = 0.f;
        for (int step = 0; step < cps; step += 4) {
            v4u kv[4]; bf16* ptr[4];
#pragma unroll
            for (int q = 0; q < 4; ++q) { const int n = dir == 0 ? s * cps + step + q : s * cps + cps - 1 - (step + q);
                ptr[q] = ST + ((size_t)(dir * 128 + n) * NTH + h) * 16384 + eg * 8; kv[q] = *(const v4u*)ptr[q]; }
#pragma unroll
            for (int q = 0; q < 4; ++q) {
                v4u o; o.x = pk2(st[0], st[1]); o.y = pk2(st[2], st[3]); o.z = pk2(st[4], st[5]); o.w = pk2(st[6], st[7]);
                *(v4u*)ptr[q] = o;
                const unsigned w[4] = {kv[q].x, kv[q].y, kv[q].z, kv[q].w};
#pragma unroll
                for (int e = 0; e < 4; ++e) { st[2 * e] = st[2 * e] * decay + bf2f((unsigned short)(w[e] & 0xffffu)); st[2 * e + 1] = st[2 * e + 1] * decay + bf2f((unsigned short)(w[e] >> 16)); }
            }
        }
    }
}

DI void ret_out_phase(const Params& P, LAS unsigned char* lds, int r, const bf16* QKV, const bf16* ST, bf16* CAT) {
    int tid_l = threadIdx.x; asm volatile("" : "+v"(tid_l)); const int tid = tid_l, lane = tid & 63, wave = __builtin_amdgcn_readfirstlane(tid >> 6), g0 = lane >> 4, li0 = lane & 15;
    const int L = r < 2 ? 2048 : 8192, cps = L / 128;
    LAS unsigned char* RA = lds; LAS unsigned char* RB = lds + 34816; LAS unsigned char* RC = lds + 69632; LAS unsigned char* RD = lds + 104448;
    const float* rc = (const float*)(P.ws + WS_ROPE); const float* rsn = rc + 8192 * 64;
    for (int u = lbid(); u < 128 * NTH; u += lgdim()) {
        int g = g0, li = li0; asm volatile("" : "+v"(g), "+v"(li));
        const int n = u / NTH, h = u % NTH;
        const int tokbase = n * 128, pos0 = (n % cps) * 128;
        const float l2f = ret_log2gamma(P, 0, h), l2b = ret_log2gamma(P, 1, h);
        const bf16* stf = ST + ((size_t)(0 * 128 + n) * NTH + h) * 16384; const bf16* stb = ST + ((size_t)(1 * 128 + n) * NTH + h) * 16384;
        _Pragma("unroll") for (int it_ = 0; it_ < 4; ++it_) { const int task = tid + 512 * it_; const int which = task >> 10, j = (task >> 3) & 127, dg = task & 7;
            const bf16* kp = QKV + (size_t)(tokbase + j) * NIN0 + which * 1536 + h * 128 + dg * 8;
            const bf16x8 lo = __builtin_nontemporal_load((const bf16x8*)kp), hi = __builtin_nontemporal_load((const bf16x8*)(kp + 64));
            const float* cp = rc + (size_t)(pos0 + j) * 64 + dg * 8; const float* sp = rsn + (size_t)(pos0 + j) * 64 + dg * 8;
            const f32x4 c0 = *(const f32x4*)cp, c1 = *(const f32x4*)(cp + 4), s0 = *(const f32x4*)sp, s1 = *(const f32x4*)(sp + 4);
            const float w = which ? QK_SCALE : 1.0f;
            float o1[8], o2[8];
#pragma unroll
            for (int e = 0; e < 8; ++e) { const float x1 = bf2f((unsigned short)lo[e]), x2 = bf2f((unsigned short)hi[e]); const float c = e < 4 ? c0[e & 3] : c1[e & 3], sn = e < 4 ? s0[e & 3] : s1[e & 3];
                o1[e] = (x1 * c - x2 * sn) * w; o2[e] = (x1 * sn + x2 * c) * w; }
            v4u a, b;
            a.x = pk2(o1[0], o1[1]); a.y = pk2(o1[2], o1[3]); a.z = pk2(o1[4], o1[5]); a.w = pk2(o1[6], o1[7]);
            b.x = pk2(o2[0], o2[1]); b.y = pk2(o2[2], o2[3]); b.z = pk2(o2[4], o2[5]); b.w = pk2(o2[6], o2[7]);
            LAS unsigned char* dst = which ? RB : RA;
            *(LAS v4u*)(dst + j * PITCH + dg * 16) = a; *(LAS v4u*)(dst + j * PITCH + 128 + dg * 16) = b; }
        _Pragma("unroll") for (int it_ = 0; it_ < 4; ++it_) { const int task = tid + 512 * it_; const int j = task >> 4, c = task & 15;
            *(LAS v4u*)(RC + j * PITCH + c * 16) = __builtin_nontemporal_load((const v4u*)(QKV + (size_t)(tokbase + j) * NIN0 + 3072 + h * 128 + c * 8));
            *(LAS v4u*)(RD + j * PITCH + c * 16) = __builtin_nontemporal_load((const v4u*)(stf + j * 128 + c * 8)); }
        __syncthreads();
        v4u sbr[4];
        _Pragma("unroll") for (int it_ = 0; it_ < 4; ++it_) { const int task = tid + 512 * it_; sbr[it_] = __builtin_nontemporal_load((const v4u*)(stb + (task >> 4) * 128 + (task & 15) * 8)); }
        const size_t tok = (size_t)(tokbase + 16 * wave + li);
        v2u gtv[8];
#pragma unroll
        for (int t = 0; t < 8; ++t) gtv[t] = *(const v2u*)(QKV + tok * NIN0 + 4608 + h * 128 + 16 * t + 4 * g);
        const int itok = 16 * wave + li;
        bf16x8 pf[4];
        {
            f32x4 sacc[8];
#pragma unroll
            for (int t = 0; t < 8; ++t) sacc[t] = (f32x4){0.f, 0.f, 0.f, 0.f};
#pragma unroll
            for (int ks = 0; ks < 4; ++ks) { const bf16x8 qb = frag_row(RA, PITCH, 16 * wave, 32 * ks, lane);
#pragma unroll
                for (int t = 0; t < 8; ++t) sacc[t] = mfma16(frag_row(RB, PITCH, 16 * t, 32 * ks, lane), qb, sacc[t]); }
#pragma unroll
            for (int t = 0; t < 8; ++t)
#pragma unroll
                for (int i = 0; i < 4; ++i) { const int dd = itok - (16 * t + 4 * g + i);
                    sacc[t][i] *= dd >= 0 ? fexp2((float)dd * l2f) : fexp2((float)(-dd) * l2b); }
#pragma unroll
            for (int sx = 0; sx < 4; ++sx) { v4u w; w.x = pk2(sacc[2 * sx][0], sacc[2 * sx][1]); w.y = pk2(sacc[2 * sx][2], sacc[2 * sx][3]);
                w.z = pk2(sacc[2 * sx + 1][0], sacc[2 * sx + 1][1]); w.w = pk2(sacc[2 * sx + 1][2], sacc[2 * sx + 1][3]); pf[sx] = __builtin_bit_cast(bf16x8, w); }
        }
        f32x4 yacc[8];
#pragma unroll
        for (int t = 0; t < 8; ++t) yacc[t] = (f32x4){0.f, 0.f, 0.f, 0.f};
#pragma unroll
        for (int sx = 0; sx < 4; ++sx)
#pragma unroll
            for (int t = 0; t < 8; ++t) { yacc[t] = mfma16(frag_tr2(RC, PITCH, 32 * sx, 32 * sx + 16, 16 * t, lane), pf[sx], yacc[t]); if ((t & 3) == 3) __builtin_amdgcn_sched_barrier(0); }
        {
            f32x4 tacc[8];
#pragma unroll
            for (int t = 0; t < 8; ++t) tacc[t] = (f32x4){0.f, 0.f, 0.f, 0.f};
#pragma unroll
            for (int ks = 0; ks < 4; ++ks) { const bf16x8 qb = frag_row(RA, PITCH, 16 * wave, 32 * ks, lane);
#pragma unroll
                for (int t = 0; t < 8; ++t) { tacc[t] = mfma16(frag_tr(RD, PITCH, 32 * ks, 16 * t, lane), qb, tacc[t]); if ((t & 3) == 3) __builtin_amdgcn_sched_barrier(0); } }
            const float qd = fexp2((float)(itok + 1) * l2f);
#pragma unroll
            for (int t = 0; t < 8; ++t) yacc[t] = yacc[t] + tacc[t] * qd;
        }
        __syncthreads();
        _Pragma("unroll") for (int it_ = 0; it_ < 4; ++it_) { const int task = tid + 512 * it_; *(LAS v4u*)(RB + (task >> 4) * PITCH + (task & 15) * 16) = sbr[it_]; }
        __syncthreads();
        {
            f32x4 tacc[8];
#pragma unroll
            for (int t = 0; t < 8; ++t) tacc[t] = (f32x4){0.f, 0.f, 0.f, 0.f};
#pragma unroll
            for (int ks = 0; ks < 4; ++ks) { const bf16x8 qb = frag_row(RA, PITCH, 16 * wave, 32 * ks, lane);
#pragma unroll
                for (int t = 0; t < 8; ++t) { tacc[t] = mfma16(frag_tr(RB, PITCH, 32 * ks, 16 * t, lane), qb, tacc[t]); if ((t & 3) == 3) __builtin_amdgcn_sched_barrier(0); } }
            const float qd = fexp2((float)(128 - itok) * l2b);
#pragma unroll
            for (int t = 0; t < 8; ++t) yacc[t] = yacc[t] + tacc[t] * qd;
        }
        float ss = 0.f;
#pragma unroll
        for (int t = 0; t < 8; ++t) ss += (yacc[t][0] * yacc[t][0] + yacc[t][1] * yacc[t][1]) + (yacc[t][2] * yacc[t][2] + yacc[t][3] * yacc[t][3]);
        ss += __shfl_xor(ss, 16); ss += __shfl_xor(ss, 32);
        const float rstd = 1.0f / sqrtf(ss * (1.0f / 128.0f) + EPS);
#pragma unroll
        for (int t = 0; t < 8; ++t) { const f32x4 gt = bf4(gtv[t]); f32x4 o;
#pragma unroll
            for (int i = 0; i < 4; ++i) o[i] = gt[i] * __builtin_amdgcn_rcpf(1.0f + fexp2(-gt[i] * LOG2E)) * yacc[t][i] * rstd;
            v2u w; w.x = pk2(o[0], o[1]); w.y = pk2(o[2], o[3]);
            *(v2u*)(CAT + tok * D + h * 128 + 16 * t + 4 * g) = w; }
        __syncthreads();
    }
}

__global__ void __launch_bounds__(512, 2) fwd_kernel(Params P) {
    extern __shared__ __attribute__((aligned(16))) unsigned char lds_raw[];
    LAS unsigned char* lds = (LAS unsigned char*)lds_raw;
    cg::grid_group grid = cg::this_grid();
    volatile LAS unsigned* bst = (volatile LAS unsigned*)(lds + LDS_BYTES - 64);
    if (threadIdx.x < 2) bst[threadIdx.x] = 0u;
    unsigned* barw = (unsigned*)P.ws;
    if (blockIdx.x == 0) for (int i = threadIdx.x; i < XCD_BAR_WORDS; i += 512) __hip_atomic_store(barw + i, 0u, __ATOMIC_RELAXED, __HIP_MEMORY_SCOPE_AGENT);
    prologue(P, lds);
    phase_rowpass0(P, 0);
    __threadfence();
    __syncthreads();
    grid.sync();
    const XcdBarrier xbar = xcd_barrier_post(barw, bst);
    for (int step = 0; step < 1 + 16 * NROUND; ++step) {
        int st = step; asm volatile("" : "+s"(st));
#if defined(__HIP_DEVICE_COMPILE__)
        const __attribute__((address_space(4))) Params* kp = (const __attribute__((address_space(4))) Params*)__builtin_amdgcn_kernarg_segment_ptr();
        asm volatile("" : "+s"(kp));
        Params Q;
        Q.x_prompt = kp->x_prompt; Q.x_sample = kp->x_sample; Q.mem_prompt = kp->mem_prompt; Q.mem_sample = kp->mem_sample; Q.norm_gain = kp->norm_gain; Q.mem_norm_gain = kp->mem_norm_gain;
        Q.w_mem_kv = kp->w_mem_kv; Q.w_out = kp->w_out; Q.w_mlp_in = kp->w_mlp_in; Q.w_mlp_out = kp->w_mlp_out; Q.w_in_ret = kp->w_in_ret; Q.ret_decay = kp->ret_decay;
        Q.w_in_na = kp->w_in_na; Q.na_rpb = kp->na_rpb; Q.out = kp->out; Q.ws = kp->ws;
#else
        Params Q = P;
#endif
        asm volatile("" : "+s"(Q.x_prompt), "+s"(Q.x_sample), "+s"(Q.mem_prompt), "+s"(Q.mem_sample), "+s"(Q.norm_gain), "+s"(Q.mem_norm_gain), "+s"(Q.w_mem_kv), "+s"(Q.w_out));
        asm volatile("" : "+s"(Q.w_mlp_in), "+s"(Q.w_mlp_out), "+s"(Q.w_in_ret), "+s"(Q.ret_decay), "+s"(Q.w_in_na), "+s"(Q.na_rpb), "+s"(Q.out), "+s"(Q.ws));
        unsigned char* ws = Q.ws;
        bf16* H = (bf16*)(ws + WS_X16); const float* RS = (const float*)(ws + WS_RSTD); bf16* QKV = (bf16*)(ws + WS_QKV); bf16* CAT = (bf16*)(ws + WS_CAT); bf16* MIX = (bf16*)(ws + WS_MIX); bf16* ST = (bf16*)(ws + WS_ST);
        const int si = st < 1 ? -1 : (st - 1) & 15, r = st < 1 ? 0 : (st - 1) >> 4;
        const int layer = si >= 9 ? 1 : 0;
        const float* gn = Q.norm_gain + (size_t)layer * 4 * D;
        if (st < 1 || si == 0 || si == 4 || si == 6 || si == 7 || si == 9 || si == 11 || si == 13 || si == 14) {
            const bool split = st < 1 && (gridDim.x & 1) == 0;
            const int nrep = (st < 1 && !split) ? 2 : 1;
            for (int rep = 0; rep < nrep; ++rep) {
                const bf16* A; const bf16* Bt; bf16* O; const float* rs = nullptr; int M = MC, N, K, act = 0, G = (int)gridDim.x, c = (int)blockIdx.x;
                if (st < 1) { const int ml = split ? (int)(blockIdx.x & 1) : rep; if (split) { G >>= 1; c >>= 1; }
                    A = (const bf16*)(ws + WS_MEMN) + (size_t)ml * MEMROWS * D; Bt = (const bf16*)(ws + WS_WMEM) + (size_t)ml * 1024 * D; O = (bf16*)(ws + WS_MEMKV) + (size_t)ml * MEMROWS * 1024; M = MEMROWS; N = 1024; K = D; }
                else if (si == 0) { A = H; rs = RS; Bt = (const bf16*)(ws + WS_WIN0); O = QKV; N = NIN0; K = D; }
                else if (si == 9) { A = H; rs = RS; Bt = (const bf16*)(ws + WS_WIN1); O = QKV; N = NIN1; K = D; }
                else if (si == 4 || si == 11) { A = CAT; Bt = (const bf16*)(ws + WS_WOUT) + (size_t)layer * D * D; O = MIX; N = D; K = D; }
                else if (si == 6 || si == 13) { A = H; rs = RS; Bt = (const bf16*)(ws + WS_WMI) + (size_t)layer * D * DFF; O = QKV; N = DFF; K = D; act = 1; }
                else { A = QKV; Bt = (const bf16*)(ws + WS_WMO) + (size_t)layer * D * DFF; O = MIX; N = D; K = DFF; }
                run_gemm(lds, A, Bt, M, N, K, O, N, act, G, c, rs);
            }
        } else if (si == 1 || si == 10) {
            mem_attn_phase(Q, lds, r, layer, QKV, layer ? NIN1 : NIN0, layer ? 4608 : 6144, CAT);
            if (si == 1) ret_kv_phase(Q, lds, r, QKV, ST); else na_phase(Q, lds, r, QKV, CAT);
        } else if (si == 2) ret_scan_phase(Q, r, ST);
        else if (si == 3) ret_out_phase(Q, lds, r, QKV, ST, CAT);
        else if (si == 5 || si == 8 || si == 12) phase_rowpass<false>(Q, r, (si == 8) ? gn + 3 * D : gn + D);
        else { phase_rowpass<true>(Q, r, gn + 3 * D); if (r + 1 < NROUND) phase_rowpass0(Q, r + 1); }
        if (st + 1 < 1 + 16 * NROUND) { XcdBarrier xb = xbar; asm volatile("" : "+s"(xb.bar), "+s"(xb.x));
            xcd_barrier(xb); }
    }
}

extern "C" void kernel_launch(void* const* d_in, const int* in_sizes, int n_in, void* d_out, int out_size, void* d_ws, size_t ws_size, hipStream_t stream) {
    static int grid = 0;
    if (grid == 0) {
        if (n_in != 14 || ws_size < WS_END) { fprintf(stderr, "kernel_launch: need 14 inputs and >= %zu bytes of workspace; got n_in %d, ws %zu\n", (size_t)WS_END, n_in, ws_size); grid = -1; return; }
        int dev = 0, cus = 0, per_cu = 0;
        (void)hipGetDevice(&dev); (void)hipDeviceGetAttribute(&cus, hipDeviceAttributeMultiprocessorCount, dev);
        if (hipFuncSetAttribute((const void*)fwd_kernel, hipFuncAttributeMaxDynamicSharedMemorySize, LDS_BYTES) != hipSuccess) { fprintf(stderr, "kernel_launch: hipFuncSetAttribute failed\n"); grid = -1; return; }
        if (hipOccupancyMaxActiveBlocksPerMultiprocessor(&per_cu, (const void*)fwd_kernel, 512, LDS_BYTES) != hipSuccess || per_cu < 1) { fprintf(stderr, "kernel_launch: occupancy query says %d blocks per CU\n", per_cu); per_cu = 1; }
        (void)hipGetLastError();
        grid = cus > 0 ? cus : 256;
    }
    if (grid < 0) return;
    Params p{};
    p.x_prompt = (const float*)d_in[0]; p.x_sample = (const float*)d_in[1]; p.mem_prompt = (const float*)d_in[2]; p.mem_sample = (const float*)d_in[3];
    p.norm_gain = (const float*)d_in[4]; p.mem_norm_gain = (const float*)d_in[5]; p.w_mem_kv = (const float*)d_in[6]; p.w_out = (const float*)d_in[7];
    p.w_mlp_in = (const float*)d_in[8]; p.w_mlp_out = (const float*)d_in[9]; p.w_in_ret = (const float*)d_in[10]; p.ret_decay = (const float*)d_in[11];
    p.w_in_na = (const float*)d_in[12]; p.na_rpb = (const float*)d_in[13];
    p.out = (float*)d_out; p.ws = (unsigned char*)d_ws;
    void* args[] = {&p};
    const hipError_t e = hipLaunchCooperativeKernel((const void*)fwd_kernel, dim3(grid), dim3(512), args, LDS_BYTES, stream);
    if (e != hipSuccess) fprintf(stderr, "kernel_launch: cooperative launch failed: %s (grid %d)\n", hipGetErrorString(e), grid);
}
```
